# Optimizing an MI355X kernel written in HIP

```python
import math
import jax, jax.numpy as jnp
from jax import lax
import numpy as np

D_MODEL = 1024
BATCH = 4
SEQ = 4096
DEPTH = 2

HEAD_DIM = 64
GROUP_W = D_MODEL // 4
MIX_W = 4 * GROUP_W
DIFF_HEADS = GROUP_W // HEAD_DIM
DIFF_QK_DIM = HEAD_DIM // 2
CONV_W = GROUP_W
CONV_KERNEL = 31
GMLP_HEADS = GROUP_W // HEAD_DIM
GMLP_W = GROUP_W
CHUNK = 128
FOX_HEADS = GROUP_W // HEAD_DIM
FOX_W = GROUP_W
D_FF = ((8 * D_MODEL // 3 + 127) // 128) * 128
Q_BLOCK = 128
N_MOD = 9
EPS = 1e-6
NEG_INF = -1e30

DIFF_Q0 = 0
DIFF_K0 = DIFF_Q0 + DIFF_HEADS * 2 * DIFF_QK_DIM
DIFF_V0 = DIFF_K0 + DIFF_HEADS * 2 * DIFF_QK_DIM
CONV0 = DIFF_V0 + DIFF_HEADS * HEAD_DIM
GMLP0 = CONV0 + 2 * CONV_W
FOX_Q0 = GMLP0 + 2 * GMLP_W
FOX_K0 = FOX_Q0 + FOX_W
FOX_V0 = FOX_K0 + FOX_W
FOX_F0 = FOX_V0 + FOX_W
IN_COLS = FOX_F0 + FOX_HEADS

kernel_name = "hybrid_parallel_group_decoder"


def _rms_norm(x, g):
    xf = x.astype(jnp.float32)
    y = xf * lax.rsqrt(jnp.mean(xf * xf, axis=-1, keepdims=True) + EPS)
    return (y * g.astype(jnp.float32)).astype(x.dtype)


def _layer_norm(x, g, b):
    xf = x.astype(jnp.float32)
    mu = jnp.mean(xf, axis=-1, keepdims=True)
    var = jnp.mean(jnp.square(xf - mu), axis=-1, keepdims=True)
    y = (xf - mu) * lax.rsqrt(var + EPS)
    return (y * g.astype(jnp.float32) + b.astype(jnp.float32)).astype(x.dtype)


def _modulate(xn, shift, scale):
    return xn * (1 + scale[:, None, :]) + shift[:, None, :]


def _swiglu(x, w_in, w_out):
    gate, up = jnp.split(x @ w_in, 2, axis=-1)
    return (jax.nn.silu(gate) * up) @ w_out


def _differential_attention(q, k, v, lam, lam_init, out_g):
    B, S, H, _, dq = q.shape
    dv = v.shape[-1]
    nb = S // Q_BLOCK
    q_blocks = jnp.moveaxis(q.reshape(B, nb, Q_BLOCK, H, 2, dq), 1, 0)
    k_pos = jnp.arange(S)
    scale = dq ** -0.5

    def one_block(args):
        qi, i = args
        s = jnp.einsum('bqhcd,bkhcd->bhcqk', qi, k).astype(jnp.float32) * scale
        q_pos = i * Q_BLOCK + jnp.arange(Q_BLOCK)
        causal = k_pos[None, :] <= q_pos[:, None]
        p = jax.nn.softmax(jnp.where(causal, s, NEG_INF), axis=-1)
        a = p[:, :, 0] - lam * p[:, :, 1]
        return jnp.einsum('bhqk,bkhe->bqhe', a.astype(v.dtype), v)

    o = lax.map(one_block, (q_blocks, jnp.arange(nb)))
    o = jnp.moveaxis(o, 0, 1).reshape(B, S, H, dv)
    o = _rms_norm(o, out_g) * (1.0 - lam_init)
    return o.reshape(B, S, H * dv)


def _conformer_conv(z, w, b, ng, nb_):
    a, g = jnp.split(z, 2, axis=-1)
    y = a * jax.nn.sigmoid(g)
    y = lax.conv_general_dilated(
        y, w[:, None, :].astype(y.dtype), window_strides=(1,),
        padding=[(CONV_KERNEL - 1, 0)],
        dimension_numbers=('NWC', 'WIO', 'NWC'),
        feature_group_count=CONV_W) + b
    return jax.nn.silu(_layer_norm(y, ng, nb_))


def _chunked_spatial_gating(z, ng, nb_, ws, bs):
    u, v = jnp.split(jax.nn.gelu(z), 2, axis=-1)
    v = _layer_norm(v, ng, nb_)
    B, S, _ = v.shape
    nc = S // CHUNK
    vh = v.reshape(B, nc, CHUNK, GMLP_HEADS, HEAD_DIM)
    w = ws * jnp.tril(jnp.ones((CHUNK, CHUNK), ws.dtype))[None]
    s = jnp.einsum('hts,bnshd->bnthd', w, vh) + jnp.transpose(bs)[None, None, :, :, None]
    return u * s.reshape(B, S, GMLP_W)


def _forgetting_attention(q, k, v, log_f):
    B, S, H, d = q.shape
    nb = S // Q_BLOCK
    cum = jnp.cumsum(log_f.astype(jnp.float32), axis=1)
    q_blocks = jnp.moveaxis(q.reshape(B, nb, Q_BLOCK, H, d), 1, 0)
    c_blocks = jnp.moveaxis(cum.reshape(B, nb, Q_BLOCK, H), 1, 0)
    cum_k = jnp.transpose(cum, (0, 2, 1))
    k_pos = jnp.arange(S)
    scale = d ** -0.5

    def one_block(args):
        qi, ci, i = args
        s = jnp.einsum('bqhd,bkhd->bhqk', qi, k).astype(jnp.float32) * scale
        s = s + jnp.transpose(ci, (0, 2, 1))[..., None] - cum_k[:, :, None, :]
        q_pos = i * Q_BLOCK + jnp.arange(Q_BLOCK)
        causal = k_pos[None, :] <= q_pos[:, None]
        p = jax.nn.softmax(jnp.where(causal, s, NEG_INF), axis=-1)
        return jnp.einsum('bhqk,bkhd->bqhd', p.astype(v.dtype), v)

    o = lax.map(one_block, (q_blocks, c_blocks, jnp.arange(nb)))
    return jnp.moveaxis(o, 0, 1).reshape(B, S, H * d)


def setup_inputs(seed: int = 0) -> dict:
    key = jax.random.key(seed)
    ks = jax.random.split(key, 24)
    f32 = jnp.float32

    def nrm(k, shape, s):
        return jax.random.normal(k, shape, f32) * s

    L = DEPTH
    return {
        'x': nrm(ks[0], (BATCH, SEQ, D_MODEL), 1.0),
        'c': nrm(ks[1], (BATCH, D_MODEL), 1.0),
        'ada_w': nrm(ks[2], (L, D_MODEL, N_MOD * D_MODEL), 0.5 * D_MODEL ** -0.5),
        'ada_b': nrm(ks[3], (L, N_MOD * D_MODEL), 0.02),
        'norm_g': 1.0 + nrm(ks[4], (L, 3, D_MODEL), 0.05),
        'ffn1_w_in': nrm(ks[5], (L, D_MODEL, 2 * D_FF), D_MODEL ** -0.5),
        'ffn1_w_out': nrm(ks[6], (L, D_FF, D_MODEL), D_FF ** -0.5),
        'ffn2_w_in': nrm(ks[7], (L, D_MODEL, 2 * D_FF), D_MODEL ** -0.5),
        'ffn2_w_out': nrm(ks[8], (L, D_FF, D_MODEL), D_FF ** -0.5),
        'w_in': nrm(ks[9], (L, D_MODEL, IN_COLS), D_MODEL ** -0.5),
        'w_out': nrm(ks[10], (L, MIX_W, D_MODEL), MIX_W ** -0.5),
        'diff_qk_g': 1.0 + nrm(ks[11], (L, 2, DIFF_QK_DIM), 0.05),
        'diff_lambda': nrm(ks[12], (L, 4, DIFF_QK_DIM), 0.1),
        'diff_out_g': 1.0 + nrm(ks[13], (L, HEAD_DIM), 0.05),
        'conv_w': nrm(ks[14], (L, CONV_KERNEL, CONV_W), CONV_KERNEL ** -0.5),
        'conv_b': nrm(ks[15], (L, CONV_W), 0.02),
        'conv_norm_g': 1.0 + nrm(ks[16], (L, CONV_W), 0.05),
        'conv_norm_b': nrm(ks[17], (L, CONV_W), 0.02),
        'gmlp_norm_g': 1.0 + nrm(ks[18], (L, GMLP_W), 0.05),
        'gmlp_norm_b': nrm(ks[19], (L, GMLP_W), 0.02),
        'gmlp_ws': nrm(ks[20], (L, GMLP_HEADS, CHUNK, CHUNK), CHUNK ** -0.5),
        'gmlp_bs': 1.0 + nrm(ks[21], (L, GMLP_HEADS, CHUNK), 0.1),
        'fox_qk_g': 1.0 + nrm(ks[22], (L, 2, HEAD_DIM), 0.05),
        'fox_fb': 2.0 + nrm(ks[23], (L, FOX_HEADS), 0.5),
    }


def reference(x, c, ada_w, ada_b, norm_g, ffn1_w_in, ffn1_w_out, ffn2_w_in, ffn2_w_out,
              w_in, w_out, diff_qk_g, diff_lambda, diff_out_g, conv_w, conv_b,
              conv_norm_g, conv_norm_b, gmlp_norm_g, gmlp_norm_b, gmlp_ws, gmlp_bs,
              fox_qk_g, fox_fb):
    B, S, _ = x.shape
    h = x
    cond = jax.nn.silu(c)
    for l in range(DEPTH):
        mod = cond @ ada_w[l] + ada_b[l]
        sh1, sc1, g1, sh2, sc2, g2, sh3, sc3, g3 = jnp.split(mod, N_MOD, axis=-1)

        hn = _modulate(_rms_norm(h, norm_g[l, 0]), sh1, sc1)
        h = h + 0.5 * g1[:, None, :] * _swiglu(hn, ffn1_w_in[l], ffn1_w_out[l])

        hn = _modulate(_rms_norm(h, norm_g[l, 1]), sh2, sc2)
        z = hn @ w_in[l]

        qa = _rms_norm(z[..., DIFF_Q0:DIFF_K0].reshape(B, S, DIFF_HEADS, 2, DIFF_QK_DIM), diff_qk_g[l, 0])
        ka = _rms_norm(z[..., DIFF_K0:DIFF_V0].reshape(B, S, DIFF_HEADS, 2, DIFF_QK_DIM), diff_qk_g[l, 1])
        va = z[..., DIFF_V0:CONV0].reshape(B, S, DIFF_HEADS, HEAD_DIM)
        lam_init = 0.8 - 0.6 * math.exp(-0.3 * l)
        lv = diff_lambda[l].astype(jnp.float32)
        lam = jnp.exp(jnp.sum(lv[0] * lv[1])) - jnp.exp(jnp.sum(lv[2] * lv[3])) + lam_init
        o_a = _differential_attention(qa, ka, va, lam, lam_init, diff_out_g[l])

        o_b = _conformer_conv(z[..., CONV0:GMLP0], conv_w[l], conv_b[l], conv_norm_g[l], conv_norm_b[l])

        o_c = _chunked_spatial_gating(z[..., GMLP0:FOX_Q0], gmlp_norm_g[l], gmlp_norm_b[l], gmlp_ws[l], gmlp_bs[l])

        qd = _rms_norm(z[..., FOX_Q0:FOX_K0].reshape(B, S, FOX_HEADS, HEAD_DIM), fox_qk_g[l, 0])
        kd = _rms_norm(z[..., FOX_K0:FOX_V0].reshape(B, S, FOX_HEADS, HEAD_DIM), fox_qk_g[l, 1])
        vd = z[..., FOX_V0:FOX_F0].reshape(B, S, FOX_HEADS, HEAD_DIM)
        log_f = jax.nn.log_sigmoid((z[..., FOX_F0:IN_COLS] + fox_fb[l]).astype(jnp.float32))
        o_d = _forgetting_attention(qd, kd, vd, log_f)

        mixed = jnp.concatenate([o_a, o_b, o_c, o_d], axis=-1)
        h = h + g2[:, None, :] * (mixed @ w_out[l])

        hn = _modulate(_rms_norm(h, norm_g[l, 2]), sh3, sc3)
        h = h + 0.5 * g3[:, None, :] * _swiglu(hn, ffn2_w_in[l], ffn2_w_out[l])
    return h
```

```cpp
#include <hip/hip_runtime.h>
#include <hip/hip_cooperative_groups.h>
#include <cstdio>
#include <cstdint>
namespace cg = cooperative_groups;
namespace pg8 {
#define PG8_LAS __attribute__((address_space(3)))
typedef unsigned short bf16_t;
typedef short bf16x8 __attribute__((ext_vector_type(8)));
typedef float f32x4 __attribute__((ext_vector_type(4)));
typedef unsigned u32x4 __attribute__((ext_vector_type(4)));
constexpr int BM = 256, BK = 64, HALF = 128, HTB = HALF * BK * 2  , STAGE_BYTES = 8 * HTB, NXCD = 8, WGM = 8;

__host__ __device__ __forceinline__ int lds_byte(int r, int c) { const int st = (r >> 4) * 2 + (c >> 5), rr = r & 15, cc = c & 31, ob = rr * 64 + cc * 2; return st * 1024 + (ob ^ (((ob >> 9) & 1) << 5)); }
__host__ __device__ __forceinline__ void stage_rc(int b, int& R, int& C) { const int st = b / 1024, sb = b % 1024, swz = sb ^ (((sb >> 9) & 1) << 5); R = (st >> 1) * 16 + swz / 64; C = (st & 1) * 32 + (swz % 64) / 2; }
__host__ __device__ __forceinline__ int perm32(int rho) { const int n = rho >> 4, i = rho & 15; return 8 * (i >> 2) + 4 * n + (i & 3); }

struct Unit { int pm, pn; };
struct Gemm { const bf16_t* A; const bf16_t* Bt; int M, N, K; };

struct StaticOrder {
    int nM, nN, nwg, G, c;
    __host__ __device__ void init(int M, int N, int G_, int c_) { nM = M / BM; nN = N / BM; nwg = nM * nN; G = G_; c = c_; }
    __host__ __device__ bool next(int i, Unit& u) const {
        const long L = (long)i * G + c; if (L >= nwg) return false;
        int wgid = (int)L; { const int q = nwg / NXCD, r = nwg % NXCD, xcd = wgid % NXCD, off = wgid / NXCD; wgid = (xcd < r ? xcd * (q + 1) : r * (q + 1) + (xcd - r) * q) + off; }
        const int nig = WGM * nN, gid = wgid / nig, fm = gid * WGM, gsz = (nM - fm) < WGM ? (nM - fm) : WGM;
        u.pm = fm + ((wgid % nig) % gsz); u.pn = (wgid % nig) / gsz; return true;
    }
    __device__ __forceinline__ void a_ready(const Unit&) const {}
    __device__ __forceinline__ void done(const Unit&) const {}
};

__device__ __forceinline__ unsigned cvt_pk_bf16(float lo, float hi) { unsigned r; asm volatile("v_cvt_pk_bf16_f32 %0, %1, %2" : "=v"(r) : "v"(lo), "v"(hi)); return r; }
typedef float f32x2 __attribute__((ext_vector_type(2)));
template <class Epi, class Sched, bool ALIGN_EPI = false, bool SP2 = false>
__device__ __forceinline__ void gemm_phase(PG8_LAS unsigned char* lds, const Gemm g, const Sched& S, const Epi& E) {
    int tid = (int)threadIdx.x; asm volatile("" : "+v"(tid)); const int wid = __builtin_amdgcn_readfirstlane(tid >> 6), lane = tid & 63, wr = wid >> 2, wc = wid & 3, fr = lane & 15, fq = lane >> 4;
    const int K = g.K, nt = K / BK;
    unsigned voffA[2], voffB[2];
#pragma unroll
    for (int i = 0; i < 2; ++i) { int R, C; stage_rc(tid * 16 + i * 8192, R, C); const int Rb = Epi::PERM ? ((R & ~31) + perm32(R & 31)) : R;
        voffA[i] = (unsigned)(R * K + C) * 2u; voffB[i] = (unsigned)(Rb * K + C) * 2u; }
    const size_t kstep = (size_t)(BK * 2);
    const size_t hstep = (size_t)HALF * K * 2;
    const size_t tstep = 2 * hstep;
    const unsigned ldsw = (unsigned)wid * 1024u;
    const int aoff = lds_byte(wr * 64 + fr, fq * 8), boff = lds_byte(wc * 32 + fr, fq * 8);
#define PG8_SA(b, h) (((b) * 2 + (h)) * HTB)
#define PG8_SB(b, h) ((4 + (b) * 2 + (h)) * HTB)
#define PG8_STAGE(bufoff, gbase, voff) do { _Pragma("unroll") for (int _i = 0; _i < 2; ++_i) \
        __builtin_amdgcn_global_load_lds((const unsigned*)((const char*)(gbase) + (voff)[_i]), (PG8_LAS unsigned*)(lds + (bufoff) + ldsw + _i * 8192), 16, 0, 0); } while (0)
#define PG8_LDA(dst, b, h) do { _Pragma("unroll") for (int m = 0; m < 4; ++m) _Pragma("unroll") for (int k = 0; k < 2; ++k) dst[m][k] = *(const PG8_LAS bf16x8*)(lds + PG8_SA(b, h) + aoff + m * 2048 + k * 1024); } while (0)
#define PG8_LDB(dst, b, h) do { _Pragma("unroll") for (int n = 0; n < 2; ++n) _Pragma("unroll") for (int k = 0; k < 2; ++k) dst[n][k] = *(const PG8_LAS bf16x8*)(lds + PG8_SB(b, h) + boff + n * 2048 + k * 1024); } while (0)
#define PG8_MMA(ai, bj, At, Bt) do { __builtin_amdgcn_s_setprio(1); _Pragma("unroll") for (int m = 0; m < 4; ++m) _Pragma("unroll") for (int n = 0; n < 2; ++n) _Pragma("unroll") for (int k = 0; k < 2; ++k) \
        acc[ai][bj][m][n] = __builtin_amdgcn_mfma_f32_16x16x32_bf16(Bt[n][k], At[m][k], acc[ai][bj][m][n], 0, 0, 0); __builtin_amdgcn_s_setprio(0); } while (0)
#define PG8_WAIT_V(n) asm volatile("s_waitcnt vmcnt(" #n ")" ::: "memory")
#define PG8_WAIT_L(n) asm volatile("s_waitcnt lgkmcnt(" #n ")" ::: "memory")
#define PG8_BAR __builtin_amdgcn_s_barrier()
#define PG8_SCHED __builtin_amdgcn_sched_barrier(0)
    Unit cur, nxt; int ui = 0;
    if (!S.next(0, cur)) return;
    f32x4 acc[2][2][4][2];
#pragma unroll
    for (int a = 0; a < 2; ++a)
#pragma unroll
        for (int b = 0; b < 2; ++b)
#pragma unroll
            for (int m = 0; m < 4; ++m)
#pragma unroll
                for (int n = 0; n < 2; ++n) acc[a][b][m][n] = (f32x4){0.f, 0.f, 0.f, 0.f};
    bf16x8 At[4][2], B0[2][2], B1[2][2];
    const char* cA = (const char*)g.A + (size_t)cur.pm * tstep; const char* cB = (const char*)g.Bt + (size_t)cur.pn * tstep;
    S.a_ready(cur);
    if constexpr (SP2) {
        PG8_STAGE(PG8_SB(0, 0), cB, voffB); PG8_STAGE(PG8_SB(0, 1), cB + hstep, voffB); PG8_STAGE(PG8_SA(0, 0), cA, voffA); PG8_STAGE(PG8_SA(0, 1), cA + hstep, voffA);
        if (wr == 1) PG8_BAR;
        PG8_WAIT_V(2); PG8_BAR;
        PG8_STAGE(PG8_SB(1, 0), cB + kstep, voffB); PG8_STAGE(PG8_SA(1, 0), cA + kstep, voffA); PG8_STAGE(PG8_SB(1, 1), cB + hstep + kstep, voffB);
        PG8_WAIT_V(6); PG8_BAR;
    } else {
        PG8_STAGE(PG8_SB(0, 0), cB, voffB); PG8_STAGE(PG8_SA(0, 0), cA, voffA); PG8_STAGE(PG8_SB(0, 1), cB + hstep, voffB); PG8_STAGE(PG8_SA(0, 1), cA + hstep, voffA);
        if (wr == 1) PG8_BAR;
        PG8_WAIT_V(4); PG8_BAR;
        PG8_STAGE(PG8_SB(1, 0), cB + kstep, voffB); PG8_STAGE(PG8_SA(1, 0), cA + kstep, voffA); PG8_STAGE(PG8_SB(1, 1), cB + hstep + kstep, voffB);
        PG8_WAIT_V(6); PG8_BAR;
    }
    for (;;) {
        const bool has_next = S.next(ui + 1, nxt);
        const char* nA = has_next ? (const char*)g.A + (size_t)nxt.pm * tstep : cA; const char* nB = has_next ? (const char*)g.Bt + (size_t)nxt.pn * tstep : cB;
        for (int t = 0; t < nt; t += 2) {
            const bool last = (t == nt - 2);
            const char* a1 = cA + (size_t)(t + 1) * kstep;
            const char* a2 = last ? nA : cA + (size_t)(t + 2) * kstep; const char* b2 = last ? nB : cB + (size_t)(t + 2) * kstep;
            const char* a3 = a2 + kstep; const char* b3 = b2 + kstep;
            if (last && has_next) S.a_ready(nxt);
            if constexpr (SP2) {
            PG8_LDB(B0, 0, 0); PG8_LDB(B1, 0, 1); PG8_SCHED; PG8_LDA(At, 0, 0); PG8_STAGE(PG8_SA(1, 1), a1 + hstep, voffA);
            PG8_WAIT_V(8); PG8_WAIT_L(0); PG8_BAR; PG8_MMA(0, 0, At, B0); PG8_MMA(0, 1, At, B1); PG8_BAR; PG8_SCHED;
            PG8_LDA(At, 0, 1); PG8_STAGE(PG8_SB(0, 0), b2, voffB); PG8_STAGE(PG8_SB(0, 1), b2 + hstep, voffB); PG8_STAGE(PG8_SA(0, 0), a2, voffA);
            PG8_WAIT_V(8); PG8_WAIT_L(0); PG8_BAR; PG8_MMA(1, 0, At, B0); PG8_MMA(1, 1, At, B1); PG8_BAR; PG8_SCHED;
            PG8_LDB(B0, 1, 0); PG8_LDB(B1, 1, 1); PG8_SCHED; PG8_LDA(At, 1, 0); PG8_STAGE(PG8_SA(0, 1), a2 + hstep, voffA);
            PG8_WAIT_V(8); PG8_WAIT_L(0); PG8_BAR; PG8_MMA(0, 0, At, B0); PG8_MMA(0, 1, At, B1); PG8_BAR; PG8_SCHED;
            PG8_LDA(At, 1, 1); PG8_STAGE(PG8_SB(1, 0), b3, voffB); PG8_STAGE(PG8_SB(1, 1), b3 + hstep, voffB); PG8_STAGE(PG8_SA(1, 0), a3, voffA);
            PG8_WAIT_V(8); PG8_WAIT_L(0); PG8_BAR; PG8_MMA(1, 0, At, B0); PG8_MMA(1, 1, At, B1); PG8_BAR; PG8_SCHED;
            } else {
            PG8_LDB(B0, 0, 0); PG8_SCHED; PG8_LDA(At, 0, 0); PG8_STAGE(PG8_SA(1, 1), a1 + hstep, voffA);
            PG8_WAIT_L(8); PG8_BAR; PG8_WAIT_L(0); PG8_MMA(0, 0, At, B0); PG8_BAR; PG8_SCHED;
            PG8_LDB(B1, 0, 1); PG8_STAGE(PG8_SB(0, 0), b2, voffB);
            PG8_BAR; PG8_WAIT_L(0); PG8_MMA(0, 1, At, B1); PG8_BAR;
            PG8_LDA(At, 0, 1); PG8_STAGE(PG8_SA(0, 0), a2, voffA);
            PG8_BAR; PG8_WAIT_L(0); PG8_MMA(1, 0, At, B0); PG8_BAR; PG8_SCHED;
            PG8_STAGE(PG8_SB(0, 1), b2 + hstep, voffB);
            PG8_WAIT_V(6); PG8_BAR; PG8_MMA(1, 1, At, B1); PG8_BAR;
            PG8_LDB(B0, 1, 0); PG8_SCHED; PG8_LDA(At, 1, 0); PG8_STAGE(PG8_SA(0, 1), a2 + hstep, voffA);
            PG8_WAIT_L(8); PG8_BAR; PG8_WAIT_L(0); PG8_MMA(0, 0, At, B0); PG8_BAR; PG8_SCHED;
            PG8_LDB(B1, 1, 1); PG8_STAGE(PG8_SB(1, 0), b3, voffB);
            PG8_BAR; PG8_WAIT_L(0); PG8_MMA(0, 1, At, B1); PG8_BAR;
            PG8_LDA(At, 1, 1); PG8_STAGE(PG8_SA(1, 0), a3, voffA);
            PG8_BAR; PG8_WAIT_L(0); PG8_MMA(1, 0, At, B0); PG8_BAR; PG8_SCHED;
            PG8_STAGE(PG8_SB(1, 1), b3 + hstep, voffB);
            PG8_WAIT_V(6); PG8_BAR; PG8_MMA(1, 1, At, B1); PG8_BAR;
            }
        }
        if constexpr (ALIGN_EPI) { if (wr == 0) PG8_BAR; }
        if constexpr (!Epi::AFTER_DRAIN) { E(acc, cur, wr, wc, fr, fq); S.done(cur); }
        if (!has_next) break;
#pragma unroll
        for (int a = 0; a < 2; ++a)
#pragma unroll
            for (int b = 0; b < 2; ++b)
#pragma unroll
                for (int m = 0; m < 4; ++m)
#pragma unroll
                    for (int n = 0; n < 2; ++n) acc[a][b][m][n] = (f32x4){0.f, 0.f, 0.f, 0.f};
        cur = nxt; cA = nA; cB = nB; ++ui;
        if constexpr (ALIGN_EPI) { if (wr == 1) PG8_BAR; }
    }
    PG8_WAIT_V(0);
    if constexpr (!ALIGN_EPI) { if (wr == 0) PG8_BAR; }
    PG8_BAR;
    if constexpr (Epi::AFTER_DRAIN) { E.fused(acc, cur, wr, wc, fr, fq, lds, wid, lane); S.done(cur); }
#undef PG8_SA
#undef PG8_SB
#undef PG8_STAGE
#undef PG8_LDA
#undef PG8_LDB
#undef PG8_MMA
#undef PG8_WAIT_V
#undef PG8_WAIT_L
#undef PG8_BAR
#undef PG8_SCHED
}
}

#ifndef MK_ONE_LAUNCH
#define MK_ONE_LAUNCH 1
#endif
#define LAS __attribute__((address_space(3)))
typedef unsigned short bf16_t;
typedef unsigned v4u __attribute__((ext_vector_type(4)));
typedef unsigned v2u __attribute__((ext_vector_type(2)));
typedef float f32x4 __attribute__((ext_vector_type(4)));
typedef float f32x16 __attribute__((ext_vector_type(16)));
typedef short bf16x8 __attribute__((ext_vector_type(8)));
typedef short s16x4 __attribute__((ext_vector_type(4)));

constexpr int DM = 1024, BATCH = 4, SEQ = 4096, DEPTH = 2, M = BATCH * SEQ;
constexpr int DFF = 2816, NMODC = 9 * DM;
constexpr int INC = 2564, ZC = 2560;
constexpr int DIFF_Q0 = 0, DIFF_K0 = 256, DIFF_V0 = 512, CONV0 = 768, GMLP0 = 1280, FOX_Q0 = 1792, FOX_K0 = 2048, FOX_V0 = 2304;
constexpr float EPS = 1e-6f;
constexpr float LOG2E = 1.4426950408889634f;
constexpr int NPHASE = 2 + 7 * DEPTH;
constexpr int ZN = 2816;

constexpr size_t MiB = 1u << 20;
constexpr size_t WS_CTL = 0, CTL_BYTES = 65536, WS_XBAR = 16384, WS_PCNT = 32768;
constexpr size_t WS_MOD = 1 * MiB, WS_LOGF = 2 * MiB, WS_NEGC = 2 * MiB + 512 * 1024;
constexpr size_t WS_W1IN = 4 * MiB, WS_W1OUT = 26 * MiB, WS_W2IN = 37 * MiB, WS_W2OUT = 59 * MiB, WS_WIN = 70 * MiB, WS_WOUT = 81 * MiB;
constexpr size_t WS_XN = 85 * MiB, WS_MIX = 117 * MiB, WS_ACT = 149 * MiB, WS_Z = WS_ACT, WS_RSP = 237 * MiB, WS_END = 244 * MiB;
constexpr int LDS_MAIN = 131072, LDS_BYTES = LDS_MAIN + 1024;

struct Args {
    const float *x, *c, *ada_w, *ada_b, *norm_g, *ffn1_w_in, *ffn1_w_out, *ffn2_w_in, *ffn2_w_out, *w_in, *w_out,
        *diff_qk_g, *diff_lambda, *diff_out_g, *conv_w, *conv_b, *conv_norm_g, *conv_norm_b, *gmlp_norm_g, *gmlp_norm_b,
        *gmlp_ws, *gmlp_bs, *fox_qk_g, *fox_fb;
    float* out; unsigned char* ws; int ph_lo, ph_hi;
};

__device__ __forceinline__ int otid() { int t = (int)threadIdx.x; asm volatile("" : "+v"(t)); return t; }
__device__ __forceinline__ float shx(float v, int o) { const int idx = (((int)otid() & 63) ^ o) << 2; return __builtin_bit_cast(float, __builtin_amdgcn_ds_bpermute(idx, __builtin_bit_cast(int, v))); }
typedef const __attribute__((address_space(4))) Args CA;
#define LDS_WAIT() asm volatile("s_waitcnt lgkmcnt(0)" ::: "memory")
__device__ __forceinline__ unsigned f2bf(float f) { unsigned u = __builtin_bit_cast(unsigned, f); return (u + 0x7fffu + ((u >> 16) & 1u)) >> 16; }
typedef float f32x2_t __attribute__((ext_vector_type(2))); typedef __bf16 bf16x2_t __attribute__((ext_vector_type(2)));
__device__ __forceinline__ unsigned pk2(float lo, float hi) { f32x2_t v = {lo, hi}; bf16x2_t b = __builtin_convertvector(v, bf16x2_t); return __builtin_bit_cast(unsigned, b); }
__device__ __forceinline__ float bflo(unsigned w) { return __uint_as_float(w << 16); }
__device__ __forceinline__ float bfhi(unsigned w) { return __uint_as_float(w & 0xffff0000u); }
__device__ __forceinline__ float bf2f(bf16_t b) { return __uint_as_float((unsigned)b << 16); }
__device__ __forceinline__ float wave_sum(float v) {
#pragma unroll
    for (int o = 1; o < 64; o <<= 1) v += shx(v, o);
    return v;
}
__device__ __forceinline__ float fast_sigmoid(float x) { return __builtin_amdgcn_rcpf(1.0f + __builtin_amdgcn_exp2f(-x * LOG2E)); }
__device__ __forceinline__ float gelu_tanh(float x) { const float u = 0.7978845608028654f * (x + 0.044715f * x * x * x); return x * fast_sigmoid(2.0f * u); }
__device__ __forceinline__ int crow(int r, int hi) { return (r & 3) + 8 * (r >> 2) + 4 * hi; }


__device__ __forceinline__ void grid_barrier(unsigned* ctr, unsigned target) {
    asm volatile("s_waitcnt vmcnt(0) lgkmcnt(0)" ::: "memory");
    __syncthreads();
    if (threadIdx.x == 0) {
        __builtin_amdgcn_fence(__ATOMIC_RELEASE, "agent");
        asm volatile("s_waitcnt vmcnt(0)" ::: "memory");
        __hip_atomic_fetch_add(ctr, 1u, __ATOMIC_RELAXED, __HIP_MEMORY_SCOPE_AGENT);
        unsigned spins = 0;
        while (__hip_atomic_load(ctr, __ATOMIC_RELAXED, __HIP_MEMORY_SCOPE_AGENT) < target) { __builtin_amdgcn_s_sleep(1); if (++spins > (1u << 24)) break; }
        __builtin_amdgcn_fence(__ATOMIC_ACQUIRE, "agent");
        asm volatile("s_waitcnt vmcnt(0)" ::: "memory");
    }
    __syncthreads();
}

#define XB_TMO      128
#define XB_XCNT(j)  (256  + 64 * (j))
#define XB_XSUB(j)  (1280 + 64 * (j))
#define XB_XGEN(j)  (2304 + 64 * (j))
#define XB_TOP      3328
#define XB_TOPGEN   3392
#define XCD_BAR_WORDS 3456
#define XB_SPIN_CAP (1u << 18)

__device__ __forceinline__ unsigned xb_ld(unsigned* p)              { return __hip_atomic_load(p, __ATOMIC_RELAXED, __HIP_MEMORY_SCOPE_AGENT); }
__device__ __forceinline__ unsigned xb_add(unsigned* p, unsigned v) { return __hip_atomic_fetch_add(p, v, __ATOMIC_RELAXED, __HIP_MEMORY_SCOPE_AGENT); }
__device__ __forceinline__ unsigned xb_xcc_id() { return (unsigned)__builtin_amdgcn_s_getreg((3 << 11) | 20) & 0xFu; }
#define XB_SPIN(cond, bar) do { unsigned _sp = 0; while (cond) { __builtin_amdgcn_s_sleep(1); \
    if ((++_sp & 255u) == 0u) { if (xb_ld(&(bar)[XB_TMO])) break; if (_sp > XB_SPIN_CAP) { atomicAdd(&(bar)[XB_TMO], 1u); break; } } } } while (0)

struct XcdBarrier {
    unsigned* bar; unsigned x;
    volatile LAS unsigned* st;
};

__device__ __forceinline__ XcdBarrier xcd_barrier_post(unsigned* bar, volatile LAS unsigned* st) {
    XcdBarrier b; b.bar = bar; b.x = xb_xcc_id(); b.st = st;
    if (threadIdx.x == 0) (void)xb_add(&bar[XB_XCNT(b.x)], 1u);
    return b;
}
__device__ __forceinline__ void xcd_barrier_complete(unsigned* bar, unsigned x, unsigned& nloc, unsigned& nx) {
    const unsigned G = gridDim.x * gridDim.y * gridDim.z;
    unsigned sum, cnt, mine, sp = 0u;
    for (;;) {
        sum = 0u; cnt = 0u; mine = 0u;
#pragma unroll
        for (unsigned j = 0; j < 16; ++j) { const unsigned c = xb_ld(&bar[XB_XCNT(j)]); sum += c; cnt += (c > 0u) ? 1u : 0u; mine = (j == x) ? c : mine; }
        if (sum == G) break;
        __builtin_amdgcn_s_sleep(1);
        if ((++sp & 255u) == 0u) { if (xb_ld(&bar[XB_TMO])) break; if (sp > XB_SPIN_CAP) { atomicAdd(&bar[XB_TMO], 1u); break; } }
    }
    nloc = mine > 0u ? mine : 1u; nx = cnt > 0u ? cnt : 1u;
}

__device__ __forceinline__ void xcd_barrier(const XcdBarrier& b) {
    asm volatile("s_waitcnt vmcnt(0)" ::: "memory");
    __syncthreads();
    if (threadIdx.x == 0) {
        unsigned* bar = b.bar;
        __builtin_amdgcn_s_waitcnt(0);
        unsigned nloc = b.st[0], nx = b.st[1];
        if (nloc == 0u) { xcd_barrier_complete(bar, b.x, nloc, nx); b.st[0] = nloc; b.st[1] = nx; }
        const unsigned old = xb_add(&bar[XB_XSUB(b.x)], 1u);
        const unsigned gen = old / nloc;
        if (old + 1u == (gen + 1u) * nloc) {
            __builtin_amdgcn_fence(__ATOMIC_RELEASE, "agent");
            asm volatile("s_waitcnt vmcnt(0)" ::: "memory");
            const unsigned og = xb_add(&bar[XB_TOP], 1u);
            const unsigned tg = og / nx;
            if (og + 1u == (tg + 1u) * nx) xb_add(&bar[XB_TOPGEN], 1u);
            else XB_SPIN(xb_ld(&bar[XB_TOPGEN]) == tg, bar);
            __builtin_amdgcn_fence(__ATOMIC_ACQUIRE, "agent");
            xb_add(&bar[XB_XGEN(b.x)], 1u);
            asm volatile("s_waitcnt vmcnt(0)" ::: "memory");
        } else {
            XB_SPIN(xb_ld(&bar[XB_XGEN(b.x)]) == gen, bar);
            __builtin_amdgcn_fence(__ATOMIC_ACQUIRE, "agent");
            asm volatile("s_waitcnt vmcnt(0)" ::: "memory");
        }
    }
    __syncthreads();
}

struct EpiAll {
    static constexpr bool PERM = true, AFTER_DRAIN = false;
    const void* Pk; int l, s;
    __device__ __forceinline__ void operator()(const f32x4 (&acc)[2][2][4][2], const pg8::Unit& u, int wr, int wc, int fr, int fq) const;
};
__device__ __forceinline__ void epi_all_run(const void* Pk_, int l, int s, const f32x4 (&acc)[2][2][4][2], const pg8::Unit& u, int wr, int wc, int fr, int fq);
__device__ __forceinline__ void EpiAll::operator()(const f32x4 (&acc)[2][2][4][2], const pg8::Unit& u, int wr, int wc, int fr, int fq) const { epi_all_run(Pk, l, s, acc, u, wr, wc, fr, fq); }
__device__ __forceinline__ void epi_all_run(const void* Pk_, int l, int s, const f32x4 (&acc)[2][2][4][2], const pg8::Unit& u, int wr, int wc, int fr, int fq) {
        CA* Pl = (CA*)Pk_; asm volatile("" : "+s"(Pl), "+s"(l), "+s"(s)); CA& A = *Pl;
        unsigned char* const ws = A.ws;
        const int row0 = u.pm * 256 + wr * 64 + fr; const int b = u.pm >> 4;
        if (s == 0 || s == 5) {
            bf16_t* O = (bf16_t*)(ws + WS_ACT);
            const int col0 = u.pn * 128 + wc * 32 + 8 * fq;
#pragma unroll
            for (int ai = 0; ai < 2; ++ai)
#pragma unroll
                for (int m = 0; m < 4; ++m) {
                    bf16_t* rowp = O + (size_t)(row0 + ai * 128 + m * 16) * DFF + col0;
                    float r[8];
#pragma unroll
                    for (int n = 0; n < 2; ++n)
#pragma unroll
                        for (int j = 0; j < 4; ++j) { const float g = acc[ai][0][m][n][j], up = acc[ai][1][m][n][j]; r[n * 4 + j] = g * fast_sigmoid(g) * up; }
                    v4u w; w.x = pk2(r[0], r[1]); w.y = pk2(r[2], r[3]); w.z = pk2(r[4], r[5]); w.w = pk2(r[6], r[7]);
                    *(v4u*)rowp = w;
                }
        } else if (s == 2) {
            bf16_t* O = (bf16_t*)(ws + WS_Z);
            const int col0 = u.pn * 256 + wc * 32 + 8 * fq;
            if (u.pn == 0 || u.pn == 1 || u.pn == 7 || u.pn == 8) {
                const bool fox = u.pn >= 7; const int isk = fox ? u.pn - 7 : u.pn;
                const float* gp = fox ? A.fox_qk_g + l * 128 + isk * 64 : A.diff_qk_g + l * 64 + isk * 32;
                const float qs = isk ? 1.0f : (fox ? 0.125f : 0.17677669529663687f) * LOG2E;
                f32x4 g4[2][2];
#pragma unroll
                for (int bj = 0; bj < 2; ++bj)
#pragma unroll
                    for (int n = 0; n < 2; ++n) g4[bj][n] = *(const f32x4*)(gp + (fox ? 32 * bj : 0) + 8 * fq + 4 * n) * qs;
#pragma unroll
                for (int ai = 0; ai < 2; ++ai)
#pragma unroll
                    for (int m = 0; m < 4; ++m) {
                        bf16_t* rowp = O + (size_t)(row0 + ai * 128 + m * 16) * ZC + u.pn * 256 + 8 * fq;
                        float ssb[2];
#pragma unroll
                        for (int bj = 0; bj < 2; ++bj) { const f32x4 v0 = acc[ai][bj][m][0], v1 = acc[ai][bj][m][1];
                            float t = ((v0[0] * v0[0] + v0[1] * v0[1]) + (v0[2] * v0[2] + v0[3] * v0[3])) + ((v1[0] * v1[0] + v1[1] * v1[1]) + (v1[2] * v1[2] + v1[3] * v1[3]));
                            t += shx(t, 16); t += shx(t, 32); ssb[bj] = t; }
#pragma unroll
                        for (int bj = 0; bj < 2; ++bj) {
                            const float rs = fox ? rsqrtf((ssb[0] + ssb[1]) * (1.0f / 64.0f) + EPS) : rsqrtf(ssb[bj] * (1.0f / 32.0f) + EPS);
                            const f32x4 v0 = acc[ai][bj][m][0] * rs * g4[bj][0], v1 = acc[ai][bj][m][1] * rs * g4[bj][1];
                            v4u w; w.x = pk2(v0[0], v0[1]); w.y = pk2(v0[2], v0[3]); w.z = pk2(v1[0], v1[1]); w.w = pk2(v1[2], v1[3]);
                            *(v4u*)(rowp + (fox ? 64 * wc + 32 * bj : 128 * bj + 32 * wc)) = w;
                        }
                    }
            } else if (u.pn < 10) {
#pragma unroll
                for (int ai = 0; ai < 2; ++ai)
#pragma unroll
                    for (int m = 0; m < 4; ++m) {
                        bf16_t* rowp = O + (size_t)(row0 + ai * 128 + m * 16) * ZC + col0;
#pragma unroll
                        for (int bj = 0; bj < 2; ++bj) {
                            const f32x4 v0 = acc[ai][bj][m][0], v1 = acc[ai][bj][m][1];
                            v4u w; w.x = pk2(v0[0], v0[1]); w.y = pk2(v0[2], v0[3]); w.z = pk2(v1[0], v1[1]); w.w = pk2(v1[2], v1[3]);
                            *(v4u*)(rowp + bj * 128) = w;
                        }
                    }
            } else if (wc == 0 && fq == 0) {
                float* logf = (float*)(ws + WS_LOGF);
                const f32x4 fbv = *(const f32x4*)(A.fox_fb + l * 4);
#pragma unroll
                for (int ai = 0; ai < 2; ++ai)
#pragma unroll
                    for (int m = 0; m < 4; ++m) {
                        const int row = row0 + ai * 128 + m * 16;
                        const f32x4 z = acc[ai][0][m][0] + fbv;
                        f32x4 ls;
#pragma unroll
                        for (int j = 0; j < 4; ++j) ls[j] = fminf(z[j], 0.f) - log1pf(expf(-fabsf(z[j])));
                        *(f32x4*)(logf + (size_t)row * 4) = ls;
                    }
            }
        } else {
            const float* MOD = (const float*)(ws + WS_MOD);
            const int gidx = (s == 1) ? 2 : (s == 4 ? 5 : 8);
            const float* base = (l == 0 && s == 1) ? A.x : A.out; float* out = A.out;
            const float* gp = MOD + (size_t)(l * 4 + b) * NMODC + gidx * DM; const float scale = (s == 4) ? 1.0f : 0.5f;
            const int nsite = 3 * l + (s == 1 ? 1 : (s == 4 ? 2 : 3));
            const int col0 = u.pn * 256 + wc * 32 + 8 * fq;
            float* slots = (float*)(ws + WS_RSP) + (size_t)nsite * M * 16;
            f32x4 gv[2][2];
#pragma unroll
            for (int bj = 0; bj < 2; ++bj)
#pragma unroll
                for (int n = 0; n < 2; ++n) gv[bj][n] = *(const f32x4*)(gp + col0 + bj * 128 + n * 4) * scale;
            f32x4 bb[2][2][2];
#pragma unroll
            for (int bj = 0; bj < 2; ++bj)
#pragma unroll
                for (int n = 0; n < 2; ++n) bb[0][bj][n] = *(const f32x4*)(base + (size_t)row0 * DM + col0 + bj * 128 + n * 4);
#pragma unroll
            for (int g = 0; g < 8; ++g) {
                const int ai = g >> 2, m = g & 3, row = row0 + ai * 128 + m * 16;
                if (g < 7) { const int rown = row0 + ((g + 1) >> 2) * 128 + ((g + 1) & 3) * 16;
#pragma unroll
                    for (int bj = 0; bj < 2; ++bj)
#pragma unroll
                        for (int n = 0; n < 2; ++n) bb[(g + 1) & 1][bj][n] = *(const f32x4*)(base + (size_t)rown * DM + col0 + bj * 128 + n * 4); }
                float ss = 0.f;
#pragma unroll
                for (int bj = 0; bj < 2; ++bj)
#pragma unroll
                    for (int n = 0; n < 2; ++n) {
                        const f32x4 h = bb[g & 1][bj][n] + gv[bj][n] * acc[ai][bj][m][n];
                        *(f32x4*)(out + (size_t)row * DM + col0 + bj * 128 + n * 4) = h;
                        ss += (h[0] * h[0] + h[1] * h[1]) + (h[2] * h[2] + h[3] * h[3]);
                    }
                if (nsite < 3 * DEPTH) {
                    ss += shx(ss, 16); ss += shx(ss, 32);
                    if (fq == 0) __hip_atomic_store(slots + ((size_t)u.pn * M + row) * 4 + wc, ss, __ATOMIC_RELAXED, __HIP_MEMORY_SCOPE_AGENT);
                }
            }
        }
}

__device__ __forceinline__ void fused_norm_tail(CA& A, int l, int s) {
    const int nsite = 3 * l + (s == 1 ? 1 : (s == 4 ? 2 : 3));
    if (nsite >= 3 * DEPTH) return;
    const int tid = otid(), lane = tid & 63, wave = __builtin_amdgcn_readfirstlane(tid >> 6);
    pg8::StaticOrder S; S.init(M, DM, (int)gridDim.x, (int)blockIdx.x); pg8::Unit u;
    if (!S.next(0, u)) return;
    unsigned char* const ws = A.ws;
    const int nl = nsite / 3, nw = nsite % 3, b = u.pm >> 4;
    const float* slots = (const float*)(ws + WS_RSP) + (size_t)nsite * M * 16;
    unsigned* cnt = (unsigned*)(ws + WS_PCNT) + ((size_t)nsite * 64 + u.pm) * 16;
    asm volatile("s_waitcnt vmcnt(0)" ::: "memory");
    __syncthreads();
    if (tid == 0) {
        __hip_atomic_fetch_add(cnt, 1u, __ATOMIC_RELAXED, __HIP_MEMORY_SCOPE_AGENT);
        unsigned spins = 0;
        while (__hip_atomic_load(cnt, __ATOMIC_RELAXED, __HIP_MEMORY_SCOPE_AGENT) < 4u) { __builtin_amdgcn_s_sleep(2); if (++spins > (1u << 22)) break; }
    }
    __syncthreads();
    const float* MODn = (const float*)(ws + WS_MOD) + (size_t)(nl * 4 + b) * NMODC + (3 * nw) * DM;
    const int col = u.pn * 256 + 4 * lane;
    const f32x4 ca = *(const f32x4*)(A.norm_g + (size_t)nsite * DM + col) * (1.0f + *(const f32x4*)(MODn + DM + col)), cb = *(const f32x4*)(MODn + col);
    const float* hbase = A.out; bf16_t* xn = (bf16_t*)(ws + WS_XN);
    float rstd_l = 0.f;
    {
        const int row = u.pm * 256 + wave * 32 + (lane & 31);
        float ss = 0.f;
#pragma unroll
        for (int t = 0; t < 4; ++t) {
            const unsigned long long* sp = (const unsigned long long*)(slots + ((size_t)t * M + row) * 4);
            const unsigned long long w0 = __hip_atomic_load(sp, __ATOMIC_RELAXED, __HIP_MEMORY_SCOPE_AGENT), w1 = __hip_atomic_load(sp + 1, __ATOMIC_RELAXED, __HIP_MEMORY_SCOPE_AGENT);
            ss += (__uint_as_float((unsigned)w0) + __uint_as_float((unsigned)(w0 >> 32))) + (__uint_as_float((unsigned)w1) + __uint_as_float((unsigned)(w1 >> 32)));
        }
        rstd_l = rsqrtf(ss * (1.0f / DM) + EPS);
    }
    f32x4 hrow[32];
#pragma unroll
    for (int r = 0; r < 32; ++r) hrow[r] = *(const f32x4*)(hbase + (size_t)(u.pm * 256 + wave * 32 + r) * DM + col);
#pragma unroll
    for (int r = 0; r < 32; ++r) {
        const int row = u.pm * 256 + wave * 32 + r;
        const float rstd = __builtin_bit_cast(float, __builtin_amdgcn_readlane(__builtin_bit_cast(int, rstd_l), r));
        const f32x4 y = hrow[r] * rstd * ca + cb;
        v2u o; o.x = pk2(y.x, y.y); o.y = pk2(y.z, y.w);
        *(v2u*)(xn + (size_t)row * DM + col) = o;
    }
}

__device__ __forceinline__ void p0_transpose_item(const float* W, int ld, int k0, int n0, bf16_t* WT, int K, int drow0, LAS float* scr, int lane, int ncols) {
    float tv[32];
#pragma unroll
    for (int i = 0; i < 32; ++i) tv[i] = (n0 + (lane & 31) < ncols) ? W[(size_t)(k0 + 2 * i + (lane >> 5)) * ld + n0 + (lane & 31)] : 0.f;
#pragma unroll
    for (int i = 0; i < 32; ++i) scr[(2 * i + (lane >> 5)) * 33 + (lane & 31)] = tv[i];
    LDS_WAIT(); asm volatile("" ::: "memory");
    const int c = lane & 7;
#pragma unroll
    for (int j = 0; j < 4; ++j) { const int n = (lane >> 3) + 8 * j; const LAS float* s = scr + (8 * c) * 33 + n;
        v4u o; o.x = pk2(s[0 * 33], s[1 * 33]); o.y = pk2(s[2 * 33], s[3 * 33]); o.z = pk2(s[4 * 33], s[5 * 33]); o.w = pk2(s[6 * 33], s[7 * 33]);
        *(v4u*)(WT + (size_t)(drow0 + n) * K + k0 + 8 * c) = o; }
    LDS_WAIT(); asm volatile("" ::: "memory");
}
constexpr int I_LAYER_FWD = 2 * (16 * 176 + 44 * 32) + 16 * 88 + 16 * 32;
__device__ __forceinline__ void weight_copies(CA& A, LAS unsigned char* lds, int it_lo, int it_hi, int wi, int nw);
__device__ __forceinline__ void p0_prologue(CA& A, LAS unsigned char* lds) {
    const int tid = otid(), lane = tid & 63, wave = __builtin_amdgcn_readfirstlane(tid >> 6);
    float* MOD = (float*)(A.ws + WS_MOD);
    LAS float* cond = (LAS float*)(lds + 8 * 16384 - 16384);
    for (int i = tid; i < 4 * DM; i += 512) { const float v = A.c[i]; cond[i] = v * fast_sigmoid(v); }
    __syncthreads();
    {
        const int gw0 = blockIdx.x * 8 + wave, NGW0 = gridDim.x * 8;
        for (int it = gw0; it < DEPTH * 144 * 16; it += NGW0) {
            const int kq = it & 15, r = it >> 4, l = r / 144, chunk = r % 144, col = chunk * 64 + lane;
            const float* wp = A.ada_w + (size_t)l * DM * NMODC + (size_t)(kq * 64) * NMODC + col;
            float wv[64];
#pragma unroll
            for (int k = 0; k < 64; ++k) wv[k] = wp[(size_t)k * NMODC];
            float a0 = 0.f, a1 = 0.f, a2 = 0.f, a3 = 0.f;
#pragma unroll
            for (int k = 0; k < 64; ++k) { const int kk = kq * 64 + k; a0 += cond[kk] * wv[k]; a1 += cond[DM + kk] * wv[k]; a2 += cond[2 * DM + kk] * wv[k]; a3 += cond[3 * DM + kk] * wv[k]; }
            if (kq == 0) { const float bb = A.ada_b[(size_t)l * NMODC + col]; a0 += bb; a1 += bb; a2 += bb; a3 += bb; }
            atomicAdd(MOD + (size_t)(l * 4 + 0) * NMODC + col, a0); atomicAdd(MOD + (size_t)(l * 4 + 1) * NMODC + col, a1);
            atomicAdd(MOD + (size_t)(l * 4 + 2) * NMODC + col, a2); atomicAdd(MOD + (size_t)(l * 4 + 3) * NMODC + col, a3);
        }
    }
    __syncthreads();
    weight_copies(A, lds, 0, (gridDim.x == 256) ? I_LAYER_FWD : DEPTH * I_LAYER_FWD, blockIdx.x * 8 + wave, gridDim.x * 8);
}
constexpr int I_FIN = 16 * 176, I_FOUT = 44 * 32, I_WIN = 16 * 88, I_WOUT = 16 * 32, I_LAYER = 2 * (I_FIN + I_FOUT) + I_WIN + I_WOUT;
__device__ __forceinline__ void weight_copies(CA& A, LAS unsigned char* lds, int it_lo, int it_hi, int wi, int nw) {
    const int tid = otid(), lane = tid & 63, wave = __builtin_amdgcn_readfirstlane(tid >> 6);
    LAS float* scr = (LAS float*)(lds + wave * 16384);
    for (int it = it_lo + wi; it < it_hi; it += nw) {
        const int l = it / I_LAYER; int r = it % I_LAYER;
        if (r < 2 * I_FIN) {
            const int which = r / I_FIN; r %= I_FIN; const int kb = r / 176, nb = r % 176, n0 = nb * 32;
            const int up = n0 >= DFF ? 1 : 0, j = n0 - up * DFF, drow0 = (j >> 7) * 256 + up * 128 + (j & 127);
            const float* W = (which ? A.ffn2_w_in : A.ffn1_w_in) + (size_t)l * DM * 2 * DFF;
            bf16_t* WT = (bf16_t*)(A.ws + (which ? WS_W2IN : WS_W1IN)) + (size_t)l * 2 * DFF * DM;
            p0_transpose_item(W, 2 * DFF, kb * 64, n0, WT, DM, drow0, scr, lane, 2 * DFF); continue;
        }
        r -= 2 * I_FIN;
        if (r < 2 * I_FOUT) {
            const int which = r / I_FOUT; r %= I_FOUT; const int kb = r / 32, nb = r % 32;
            const float* W = (which ? A.ffn2_w_out : A.ffn1_w_out) + (size_t)l * DFF * DM;
            bf16_t* WT = (bf16_t*)(A.ws + (which ? WS_W2OUT : WS_W1OUT)) + (size_t)l * DM * DFF;
            p0_transpose_item(W, DM, kb * 64, nb * 32, WT, DFF, nb * 32, scr, lane, DM); continue;
        }
        r -= 2 * I_FOUT;
        if (r < I_WIN) {
            const int kb = r / 88, nb = r % 88; int drow = nb * 32;
            if (nb >= 56 && nb < 72) { const int tile = nb >> 3, k = nb & 7; drow = tile * 256 + 128 * (k & 1) + 32 * (k >> 1); }
            p0_transpose_item(A.w_in + (size_t)l * DM * INC, INC, kb * 64, nb * 32, (bf16_t*)(A.ws + WS_WIN) + (size_t)l * ZN * DM, DM, drow, scr, lane, INC); continue;
        }
        r -= I_WIN;
        { const int kb = r / 32, nb = r % 32;
          p0_transpose_item(A.w_out + (size_t)l * DM * DM, DM, kb * 64, nb * 32, (bf16_t*)(A.ws + WS_WOUT) + (size_t)l * DM * DM, DM, nb * 32, scr, lane, DM); }
    }
}

__device__ __forceinline__ void p1_phase(CA& A) {
    const int tid = otid(), lane = tid & 63, wave = __builtin_amdgcn_readfirstlane(tid >> 6);
    const int gw = blockIdx.x * 8 + wave, NGW = gridDim.x * 8;
    const float* MOD = (const float*)(A.ws + WS_MOD);
    bf16_t* XN = (bf16_t*)(A.ws + WS_XN);
    for (int grp = gw; grp < M / 8; grp += NGW) {
        const int row0 = grp * 8, b = row0 >> 12;
        f32x4 ca[4], cb[4];
#pragma unroll
        for (int j = 0; j < 4; ++j) { const int col = 4 * lane + 256 * j;
            ca[j] = *(const f32x4*)(A.norm_g + col) * (1.0f + *(const f32x4*)(MOD + (size_t)b * NMODC + DM + col)); cb[j] = *(const f32x4*)(MOD + (size_t)b * NMODC + col); }
        for (int r = 0; r < 8; ++r) {
            const size_t row = row0 + r; f32x4 v[4]; float ss = 0.f;
#pragma unroll
            for (int j = 0; j < 4; ++j) { v[j] = *(const f32x4*)(A.x + row * DM + 4 * lane + 256 * j); ss += (v[j].x * v[j].x + v[j].y * v[j].y) + (v[j].z * v[j].z + v[j].w * v[j].w); }
            const float rstd = rsqrtf(wave_sum(ss) * (1.0f / DM) + EPS);
#pragma unroll
            for (int j = 0; j < 4; ++j) { const f32x4 y = v[j] * rstd * ca[j] + cb[j]; v2u o; o.x = pk2(y.x, y.y); o.y = pk2(y.z, y.w);
                *(v2u*)(XN + row * DM + 4 * lane + 256 * j) = o; }
        }
    }
}

__device__ __forceinline__ void cum_scan(CA& A, int l, LAS unsigned char* lds) {
    if (blockIdx.x >= 16) return;
    const int tid = otid(), lane = tid & 63, wave = tid >> 6;
    const int b = blockIdx.x >> 2, hh = blockIdx.x & 3;
    const float* LOGF = (const float*)(A.ws + WS_LOGF);
    float* NEGC = (float*)(A.ws + WS_NEGC);
    LAS float* wt = (LAS float*)lds;
    float v[8]; float run = 0.f;
#pragma unroll
    for (int i = 0; i < 8; ++i) { run += LOGF[((size_t)b * SEQ + tid * 8 + i) * 4 + hh]; v[i] = run; }
    float inc = run;
#pragma unroll
    for (int o = 1; o < 64; o <<= 1) { const float t = __shfl_up(inc, o); if (lane >= o) inc += t; }
    if (lane == 63) wt[wave] = inc;
    __syncthreads();
    float off = inc - run;
    for (int w = 0; w < wave; ++w) off += wt[w];
#pragma unroll
    for (int i = 0; i < 8; ++i) __hip_atomic_store(NEGC + (size_t)(b * 4 + hh) * SEQ + tid * 8 + i, -(v[i] + off) * LOG2E, __ATOMIC_RELAXED, __HIP_MEMORY_SCOPE_AGENT);
    asm volatile("s_waitcnt vmcnt(0)" ::: "memory");
    __syncthreads();
    if (tid == 0) __hip_atomic_store((unsigned*)(A.ws + WS_CTL) + 128 + l * 16 + blockIdx.x, 1u, __ATOMIC_RELAXED, __HIP_MEMORY_SCOPE_AGENT);
}

constexpr int AL_KS = 0, AL_KSZ = 64 * 144, AL_VT = 2 * AL_KSZ, AL_VSZ = 64 * 136, AL_NC = AL_VT + 2 * AL_VSZ, AL_O2 = 36864 + 1024;
static_assert(AL_NC + 1024 <= AL_O2 && AL_O2 + 128 * 65 * 4 <= LDS_MAIN, "attention LDS map");

template <bool DIFF>
__device__ __forceinline__ void attn_unit(CA& A, int l, int b, int hh, int qb, LAS unsigned char* lds, float lam, float lam_init) {
    constexpr int DQK = DIFF ? 32 : 64, NS = DQK / 16, QROWS = DIFF ? 128 : 256;
    const int tid = otid(), lane = tid & 63, wid = __builtin_amdgcn_readfirstlane(tid >> 6), r32 = lane & 31, hi = lane >> 5;
    const int q0 = qb * QROWS, wq = DIFF ? (wid & 3) * 32 : wid * 32, strm = DIFF ? (wid >> 2) : 0;
    const bf16_t* Zb = (const bf16_t*)(A.ws + WS_Z) + (size_t)b * SEQ * ZC;
    bf16_t* MIX = (bf16_t*)(A.ws + WS_MIX);
    const int qcol = DIFF ? (DIFF_Q0 + hh * 64 + strm * 32) : (FOX_Q0 + hh * 64);
    const int kcol = DIFF ? (DIFF_K0 + hh * 64) : (FOX_K0 + hh * 64);
    const int vcol = DIFF ? (DIFF_V0 + hh * 64) : (FOX_V0 + hh * 64);
    const float* gq = DIFF ? A.diff_qk_g + l * 64 : A.fox_qk_g + l * 128;
    const float* gk = gq + DQK;
    const int skey = tid >> 3, sch = tid & 7;
    const bf16_t* kp = Zb + (size_t)skey * ZC + kcol + 8 * sch;
    const bf16_t* vp = Zb + (size_t)lane * ZC + vcol + 8 * wid;
    const float* ncp = (const float*)(A.ws + WS_NEGC) + (size_t)(b * 4 + hh) * SEQ;
    const int NT = (q0 + QROWS) / 64;
    v4u kraw, vraw; float ncv = 0.f;
    v4u qraw[NS];
    {
        const bf16_t* qp = Zb + (size_t)(q0 + wq + r32) * ZC + qcol + 8 * hi;
#pragma unroll
        for (int s = 0; s < NS; ++s) qraw[s] = *(const v4u*)(qp + 16 * s);
    }
    { const int t0_ = DIFF ? 0 : NT - 1; kraw = *(const v4u*)(kp + (size_t)t0_ * 64 * ZC); vraw = *(const v4u*)(vp + (size_t)t0_ * 64 * ZC); }
    const float gkl = gk[lane & (DQK - 1)];
    bf16x8 qf[NS]; float qn2 = 0.f;
#pragma unroll
    for (int s = 0; s < NS; ++s) { qf[s] = __builtin_bit_cast(bf16x8, qraw[s]);
#pragma unroll
        for (int i = 0; i < 4; ++i) qn2 += bflo(qraw[s][i]) * bflo(qraw[s][i]) + bfhi(qraw[s][i]) * bfhi(qraw[s][i]); }
    qn2 += shx(qn2, 32);
    float qkb;
    {
        float gm = fabsf(gkl);
#pragma unroll
        for (int o_ = 1; o_ < 64; o_ <<= 1) gm = fmaxf(gm, shx(gm, o_));
        qkb = sqrtf(qn2) * sqrtf((float)DQK) * gm * 1.02f;
    }
#define ATT_LOAD(t) do { kraw = *(const v4u*)(kp + (size_t)(t) * 64 * ZC); vraw = *(const v4u*)(vp + (size_t)(t) * 64 * ZC); \
        if (!DIFF && tid < 64) ncv = ncp[(t) * 64 + tid]; } while (0)
#define ATT_WRITE(buf) do { *(LAS v4u*)(lds + AL_KS + (buf) * AL_KSZ + skey * 144 + sch * 16) = kraw;     \
        _Pragma("unroll") for (int i = 0; i < 4; ++i) { \
            *(LAS unsigned short*)(lds + AL_VT + (buf) * AL_VSZ + (8 * wid + 2 * i) * 136 + lane * 2) = (unsigned short)(vraw[i] & 0xffffu); \
            *(LAS unsigned short*)(lds + AL_VT + (buf) * AL_VSZ + (8 * wid + 2 * i + 1) * 136 + lane * 2) = (unsigned short)(vraw[i] >> 16); } \
        if (!DIFF && tid < 64) *(LAS float*)(lds + AL_NC + (buf) * 512 + tid * 4) = ncv; } while (0)
    if (!DIFF) {
        if (tid == 0) { const unsigned* fl = (const unsigned*)(A.ws + WS_CTL) + 128 + l * 16 + b * 4 + hh; unsigned spins = 0;
            while (__hip_atomic_load(fl, __ATOMIC_RELAXED, __HIP_MEMORY_SCOPE_AGENT) == 0u) { __builtin_amdgcn_s_sleep(2); if (++spins > (1u << 22)) break; } }
        __syncthreads();
    }
    float ncq = 0.f;
    if (!DIFF) { if (tid < 64) ncv = ncp[(NT - 1) * 64 + tid]; ncq = ncp[q0 + wq + r32]; }
    ATT_WRITE(0);
    __syncthreads();
    f32x16 o[2], ol; float m_ref = 0.f;
#pragma unroll
    for (int r = 0; r < 16; ++r) { o[0][r] = 0.f; o[1][r] = 0.f; ol[r] = 0.f; }
    f32x16 negm;
#pragma unroll
    for (int r = 0; r < 16; ++r) negm[r] = 0.f;
    const bf16x8 ones = {0x3F80, 0x3F80, 0x3F80, 0x3F80, 0x3F80, 0x3F80, 0x3F80, 0x3F80};
    const int qfirst = q0 + wq, qlast = qfirst + 31, qmine = qfirst + r32;
    const int koff = DIFF ? strm * 32 : 0;
    if (DIFF) {
        m_ref = qkb;
#pragma unroll
        for (int r = 0; r < 16; ++r) negm[r] = -qkb;
    } else {
        m_ref = qkb + ncq;
    }
    volatile LAS int* votes = (volatile LAS int*)(lds + LDS_MAIN + 64);
    bool first = true;
    for (int tt = 0; ; ++tt) {
        const int t = DIFF ? tt : NT - 1 - tt;
        const bool has_next = tt + 1 < NT;
        const int buf = tt & 1, key0 = t * 64;
        float nc_hi = 0.f;
        if (has_next) { ATT_LOAD(DIFF ? t + 1 : t - 1); if (!DIFF) nc_hi = ncp[key0 - 1]; }
        if (key0 <= qlast) {
            const LAS unsigned char* Kb = lds + AL_KS + buf * AL_KSZ;
            const LAS unsigned char* Vb = lds + AL_VT + buf * AL_VSZ;
            f32x16 p[2];
#pragma unroll
            for (int kt = 0; kt < 2; ++kt) {
                if (!DIFF) {
                    const LAS float* nc = (const LAS float*)(lds + AL_NC + buf * 512) + 32 * kt + 4 * hi;
#pragma unroll
                    for (int g = 0; g < 4; ++g) { const f32x4 c4 = *(const LAS f32x4*)(nc + 8 * g); p[kt][4 * g] = c4[0]; p[kt][4 * g + 1] = c4[1]; p[kt][4 * g + 2] = c4[2]; p[kt][4 * g + 3] = c4[3]; }
                }
#pragma unroll
                for (int s = 0; s < NS; ++s) {
                    const bf16x8 a = *(const LAS bf16x8*)(Kb + (32 * kt + r32) * 144 + (koff + 16 * s + 8 * hi) * 2);
                    if (DIFF && s == 0) p[kt] = __builtin_amdgcn_mfma_f32_32x32x16_bf16(a, qf[s], negm, 0, 0, 0);
                    else p[kt] = __builtin_amdgcn_mfma_f32_32x32x16_bf16(a, qf[s], p[kt], 0, 0, 0);
                }
            }
            if (!DIFF) {
#pragma unroll
                for (int kt = 0; kt < 2; ++kt)
#pragma unroll
                    for (int r = 0; r < 16; ++r) p[kt][r] -= m_ref;
            }
            if (key0 + 63 > qfirst) {
#pragma unroll
                for (int kt = 0; kt < 2; ++kt)
#pragma unroll
                    for (int r = 0; r < 16; ++r) if (key0 + 32 * kt + crow(r, hi) > qmine) p[kt][r] = -1e30f;
            }
            first = false;
#pragma unroll
            for (int kt = 0; kt < 2; ++kt)
#pragma unroll
                for (int r = 0; r < 16; ++r) p[kt][r] = __builtin_amdgcn_exp2f(p[kt][r]);
            bf16x8 pb[2][2];
#pragma unroll
            for (int kt = 0; kt < 2; ++kt)
#pragma unroll
                for (int i = 0; i < 2; ++i) { v4u w;
#pragma unroll
                    for (int j = 0; j < 4; ++j) w[j] = pk2(p[kt][8 * i + 2 * j], p[kt][8 * i + 2 * j + 1]);
                    pb[kt][i] = __builtin_bit_cast(bf16x8, w); }
#pragma unroll
            for (int kt = 0; kt < 2; ++kt)
#pragma unroll
                for (int i = 0; i < 2; ++i) {
#pragma unroll
                    for (int dt = 0; dt < 2; ++dt) {
                        const LAS unsigned char* vq = Vb + (32 * dt + r32) * 136 + (32 * kt + 16 * i + 4 * hi) * 2;
                        const s16x4 lo = *(const LAS s16x4*)vq, h4 = *(const LAS s16x4*)(vq + 16);
                        const bf16x8 a = {lo[0], lo[1], lo[2], lo[3], h4[0], h4[1], h4[2], h4[3]};
                        o[dt] = __builtin_amdgcn_mfma_f32_32x32x16_bf16(a, pb[kt][i], o[dt], 0, 0, 0);
                    }
                    ol = __builtin_amdgcn_mfma_f32_32x32x16_bf16(ones, pb[kt][i], ol, 0, 0, 0);
                }
        }
        if (has_next) ATT_WRITE(buf ^ 1);
        if (!DIFF) {
            const int vote = (!first && !__any(nc_hi + qkb - m_ref + 2.0f * qkb >= -48.0f)) ? 1 : 0;
            if (lane == 0) votes[(tt & 1) * 8 + wid] = vote;
        }
        __syncthreads();
        if (!has_next) break;
        if (!DIFF) {
            const int pb_ = (tt & 1) * 8;
            const int all = votes[pb_] & votes[pb_ + 1] & votes[pb_ + 2] & votes[pb_ + 3] & votes[pb_ + 4] & votes[pb_ + 5] & votes[pb_ + 6] & votes[pb_ + 7];
            if (all) break;
        }
    }
#undef ATT_LOAD
#undef ATT_WRITE
    const float inv = 1.0f / ol[0];
    const size_t orow = (size_t)b * SEQ + q0 + wq + r32;
    if (!DIFF) {
#pragma unroll
        for (int dt = 0; dt < 2; ++dt)
#pragma unroll
            for (int g = 0; g < 4; ++g) {
                v2u w; w.x = pk2(o[dt][4 * g] * inv, o[dt][4 * g + 1] * inv); w.y = pk2(o[dt][4 * g + 2] * inv, o[dt][4 * g + 3] * inv);
                *(v2u*)(MIX + orow * DM + 768 + hh * 64 + 32 * dt + 8 * g + 4 * hi) = w;
            }
    } else {
        LAS float* O2 = (LAS float*)(lds + AL_O2);
        if (strm == 1) {
#pragma unroll
            for (int dt = 0; dt < 2; ++dt)
#pragma unroll
                for (int r = 0; r < 16; ++r) O2[(wq + r32) * 65 + 32 * dt + crow(r, hi)] = o[dt][r] * inv;
        }
        __syncthreads();
        if (strm == 0) {
            float ss = 0.f;
#pragma unroll
            for (int dt = 0; dt < 2; ++dt)
#pragma unroll
                for (int r = 0; r < 16; ++r) { const float v = o[dt][r] * inv - lam * O2[(wq + r32) * 65 + 32 * dt + crow(r, hi)]; o[dt][r] = v; ss += v * v; }
            ss += shx(ss, 32);
            const float rs = rsqrtf(ss * (1.0f / 64.0f) + EPS) * (1.0f - lam_init);
            const float* og = A.diff_out_g + l * 64;
#pragma unroll
            for (int dt = 0; dt < 2; ++dt)
#pragma unroll
                for (int g = 0; g < 4; ++g) { const int d = 32 * dt + 8 * g + 4 * hi;
                    v2u w; w.x = pk2(o[dt][4 * g] * rs * og[d], o[dt][4 * g + 1] * rs * og[d + 1]); w.y = pk2(o[dt][4 * g + 2] * rs * og[d + 2], o[dt][4 * g + 3] * rs * og[d + 3]);
                    *(v2u*)(MIX + orow * DM + hh * 64 + d) = w; }
        }
    }
}

__device__ __forceinline__ void conv_unit(CA& A, int l, int u, LAS unsigned char* lds) {
    const int tid = otid(), lane = tid & 63, wid = tid >> 6;
    const int b = u >> 6, t0 = (u & 63) * 64;
    const bf16_t* Zb = (const bf16_t*)(A.ws + WS_Z) + (size_t)b * SEQ * ZC;
    bf16_t* MIX = (bf16_t*)(A.ws + WS_MIX);
    LAS float* Y = (LAS float*)lds;
    {
        v4u araw[6], graw[6];
#pragma unroll
        for (int k = 0; k < 6; ++k) { const int idx = tid + 512 * k, r = idx >> 5, ch = idx & 31, t = t0 - 30 + r;
            araw[k] = (v4u){0u, 0u, 0u, 0u}; graw[k] = (v4u){0u, 0u, 0u, 0u};
            if (idx < 94 * 32 && t >= 0) { araw[k] = *(const v4u*)(Zb + (size_t)t * ZC + CONV0 + 8 * ch); graw[k] = *(const v4u*)(Zb + (size_t)t * ZC + CONV0 + 256 + 8 * ch); } }
#pragma unroll
        for (int k = 0; k < 6; ++k) { const int idx = tid + 512 * k, r = idx >> 5, ch = idx & 31;
            if (idx < 94 * 32) {
                const v4u a = araw[k], g = graw[k]; f32x4 y0, y1;
                y0[0] = bflo(a[0]) * fast_sigmoid(bflo(g[0])); y0[1] = bfhi(a[0]) * fast_sigmoid(bfhi(g[0]));
                y0[2] = bflo(a[1]) * fast_sigmoid(bflo(g[1])); y0[3] = bfhi(a[1]) * fast_sigmoid(bfhi(g[1]));
                y1[0] = bflo(a[2]) * fast_sigmoid(bflo(g[2])); y1[1] = bfhi(a[2]) * fast_sigmoid(bfhi(g[2]));
                y1[2] = bflo(a[3]) * fast_sigmoid(bflo(g[3])); y1[3] = bfhi(a[3]) * fast_sigmoid(bfhi(g[3]));
                *(LAS f32x4*)(Y + r * 256 + 8 * ch) = y0; *(LAS f32x4*)(Y + r * 256 + 8 * ch + 4) = y1;
            } }
    }
    __syncthreads();
    const int c = tid & 255, half = tid >> 8;
    float w[31];
#pragma unroll
    for (int j = 0; j < 31; ++j) w[j] = A.conv_w[(size_t)(l * 31 + j) * 256 + c];
    const float bias = A.conv_b[l * 256 + c];
    float win[62];
#pragma unroll
    for (int i = 0; i < 62; ++i) win[i] = Y[(32 * half + i) * 256 + c];
    __syncthreads();
#pragma unroll
    for (int t = 0; t < 32; ++t) { float acc = bias;
#pragma unroll
        for (int j = 0; j < 31; ++j) acc += w[j] * win[t + j];
        Y[(32 * half + t) * 256 + c] = acc; }
    __syncthreads();
    const f32x4 g4 = *(const f32x4*)(A.conv_norm_g + l * 256 + 4 * lane), b4 = *(const f32x4*)(A.conv_norm_b + l * 256 + 4 * lane);
#pragma unroll
    for (int i0 = 0; i0 < 8; i0 += 4) {
        f32x4 v[4]; float sm[4], sq[4];
#pragma unroll
        for (int k = 0; k < 4; ++k) { v[k] = *(const LAS f32x4*)(Y + (wid + 8 * (i0 + k)) * 256 + 4 * lane); sm[k] = (v[k].x + v[k].y) + (v[k].z + v[k].w); }
#pragma unroll
        for (int o_ = 1; o_ < 64; o_ <<= 1) {
#pragma unroll
            for (int k = 0; k < 4; ++k) sm[k] += shx(sm[k], o_);
        }
#pragma unroll
        for (int k = 0; k < 4; ++k) { v[k] = v[k] - sm[k] * (1.0f / 256.0f); sq[k] = (v[k].x * v[k].x + v[k].y * v[k].y) + (v[k].z * v[k].z + v[k].w * v[k].w); }
#pragma unroll
        for (int o_ = 1; o_ < 64; o_ <<= 1) {
#pragma unroll
            for (int k = 0; k < 4; ++k) sq[k] += shx(sq[k], o_);
        }
#pragma unroll
        for (int k = 0; k < 4; ++k) {
            const float rstd = rsqrtf(sq[k] * (1.0f / 256.0f) + EPS);
            f32x4 o = v[k] * rstd * g4 + b4;
            o.x *= fast_sigmoid(o.x); o.y *= fast_sigmoid(o.y); o.z *= fast_sigmoid(o.z); o.w *= fast_sigmoid(o.w);
            v2u wv; wv.x = pk2(o.x, o.y); wv.y = pk2(o.z, o.w);
            *(v2u*)(MIX + ((size_t)b * SEQ + t0 + wid + 8 * (i0 + k)) * DM + 256 + 4 * lane) = wv;
        }
    }
    __syncthreads();
}

__device__ __forceinline__ void gmlp_unit(CA& A, int l, int u, LAS unsigned char* lds) {
    const int tid = otid(), lane = tid & 63, wid = __builtin_amdgcn_readfirstlane(tid >> 6);
    const size_t row0 = (size_t)(u >> 5) * SEQ + (size_t)(u & 31) * 128;
    const bf16_t* Z = (const bf16_t*)(A.ws + WS_Z);
    bf16_t* MIX = (bf16_t*)(A.ws + WS_MIX);
    LAS bf16_t* Vn = (LAS bf16_t*)lds;
    {
        const f32x4 g4 = *(const f32x4*)(A.gmlp_norm_g + l * 256 + 4 * lane), b4 = *(const f32x4*)(A.gmlp_norm_b + l * 256 + 4 * lane);
        v2u raw[16];
#pragma unroll
        for (int i = 0; i < 16; ++i) raw[i] = *(const v2u*)(Z + (row0 + wid + 8 * i) * ZC + GMLP0 + 256 + 4 * lane);
#pragma unroll
        for (int i0 = 0; i0 < 16; i0 += 4) {
            f32x4 v[4]; float sm[4], sq[4];
#pragma unroll
            for (int k = 0; k < 4; ++k) { const v2u rw = raw[i0 + k];
                v[k].x = gelu_tanh(bflo(rw.x)); v[k].y = gelu_tanh(bfhi(rw.x)); v[k].z = gelu_tanh(bflo(rw.y)); v[k].w = gelu_tanh(bfhi(rw.y));
                sm[k] = (v[k].x + v[k].y) + (v[k].z + v[k].w); }
#pragma unroll
            for (int o_ = 1; o_ < 64; o_ <<= 1) {
#pragma unroll
                for (int k = 0; k < 4; ++k) sm[k] += shx(sm[k], o_);
            }
#pragma unroll
            for (int k = 0; k < 4; ++k) { v[k] = v[k] - sm[k] * (1.0f / 256.0f); sq[k] = (v[k].x * v[k].x + v[k].y * v[k].y) + (v[k].z * v[k].z + v[k].w * v[k].w); }
#pragma unroll
            for (int o_ = 1; o_ < 64; o_ <<= 1) {
#pragma unroll
                for (int k = 0; k < 4; ++k) sq[k] += shx(sq[k], o_);
            }
#pragma unroll
            for (int k = 0; k < 4; ++k) {
                const float rstd = rsqrtf(sq[k] * (1.0f / 256.0f) + EPS);
                const f32x4 o = v[k] * rstd * g4 + b4;
                v2u wv; wv.x = pk2(o.x, o.y); wv.y = pk2(o.z, o.w);
                *(LAS v2u*)(Vn + (wid + 8 * (i0 + k)) * 264 + 4 * lane) = wv;
            }
        }
    }
    __syncthreads();
    const int fr = lane & 15, quad = lane >> 4, tt = wid;
    const int nks = (16 * tt + 15) / 32 + 1;
    for (int h = 0; h < 4; ++h) {
        f32x4 wraw[4][2];
#pragma unroll
        for (int ks = 0; ks < 4; ++ks) {
            const float* wp = A.gmlp_ws + ((size_t)(l * 4 + h) * 128 + 16 * tt + fr) * 128 + 32 * ks + quad * 8;
            if (ks < nks) { wraw[ks][0] = *(const f32x4*)wp; wraw[ks][1] = *(const f32x4*)(wp + 4); }
            else { wraw[ks][0] = (f32x4){0.f, 0.f, 0.f, 0.f}; wraw[ks][1] = (f32x4){0.f, 0.f, 0.f, 0.f}; }
        }
        bf16_t uraw[4][4]; float bsv[4];
#pragma unroll
        for (int j = 0; j < 4; ++j) { const int t = 16 * tt + quad * 4 + j; bsv[j] = A.gmlp_bs[(l * 4 + h) * 128 + t];
#pragma unroll
            for (int dt = 0; dt < 4; ++dt) uraw[dt][j] = Z[(row0 + t) * ZC + GMLP0 + h * 64 + 16 * dt + fr]; }
        bf16x8 af[4];
#pragma unroll
        for (int ks = 0; ks < 4; ++ks) {
            const int t = 16 * tt + fr, s0 = 32 * ks + quad * 8;
            float e[8] = {wraw[ks][0][0], wraw[ks][0][1], wraw[ks][0][2], wraw[ks][0][3], wraw[ks][1][0], wraw[ks][1][1], wraw[ks][1][2], wraw[ks][1][3]};
#pragma unroll
            for (int j = 0; j < 8; ++j) if (s0 + j > t) e[j] = 0.f;
            v4u w; w.x = pk2(e[0], e[1]); w.y = pk2(e[2], e[3]); w.z = pk2(e[4], e[5]); w.w = pk2(e[6], e[7]);
            af[ks] = __builtin_bit_cast(bf16x8, w);
        }
#pragma unroll
        for (int dt = 0; dt < 4; ++dt) {
            const int ch = h * 64 + 16 * dt + fr;
            f32x4 acc = {0.f, 0.f, 0.f, 0.f};
#pragma unroll
            for (int ks = 0; ks < 4; ++ks) {
                if (ks < nks) {
                    bf16x8 bfr;
#pragma unroll
                    for (int j = 0; j < 8; ++j) bfr[j] = (short)Vn[(32 * ks + quad * 8 + j) * 264 + ch];
                    acc = __builtin_amdgcn_mfma_f32_16x16x32_bf16(af[ks], bfr, acc, 0, 0, 0);
                }
            }
#pragma unroll
            for (int j = 0; j < 4; ++j) {
                const int t = 16 * tt + quad * 4 + j;
                MIX[(row0 + t) * DM + 512 + ch] = (bf16_t)f2bf(gelu_tanh(bf2f(uraw[dt][j])) * (acc[j] + bsv[j]));
            }
        }
    }
    __syncthreads();
}

constexpr int MIX_ATT_ITEMS = 768, MIX_CONV_ITEMS = 256, MIX_GMLP_ITEMS = 128, MIX_ITEMS = MIX_ATT_ITEMS + MIX_CONV_ITEMS + MIX_GMLP_ITEMS;
__device__ __forceinline__ void mix_phase(CA& A0, int l, LAS unsigned char* lds) {
    const int tid = otid();
    unsigned* counter = (unsigned*)(A0.ws + WS_CTL) + 64 * l;
    volatile LAS int* slot = (volatile LAS int*)(lds + LDS_MAIN);
    float lam_init = 0.8f - 0.6f * expf(-0.3f * (float)l), lam;
    { const float* lv = A0.diff_lambda + l * 128; float s1 = 0.f, s2 = 0.f;
      for (int i = 0; i < 32; ++i) { s1 += lv[i] * lv[32 + i]; s2 += lv[64 + i] * lv[96 + i]; }
      lam = expf(s1) - expf(s2) + lam_init; }
    if (tid == 0) *slot = (int)atomicAdd(counter, 1u);
    for (;;) {
        __syncthreads();
        const int it = *slot;
        if (it >= MIX_ITEMS) break;
        __syncthreads();
        int nxt = 0; if (tid == 0) nxt = (int)atomicAdd(counter, 1u);
        asm volatile("" : "+s"(l));
        CA* Pq = &A0; asm volatile("" : "+s"(Pq)); CA& A = *Pq;
        int ait = -1;
        if (it < 256) ait = it; else if (it >= 256 + MIX_GMLP_ITEMS + MIX_CONV_ITEMS) ait = it - MIX_GMLP_ITEMS - MIX_CONV_ITEMS;
        if (ait >= 0) {
            const int level = 15 - ait / 48, r = ait % 48, grp = r / 16, bh = r % 16;
            if (grp == 0) {
 attn_unit<false>(A, l, bh >> 2, bh & 3, level, lds, lam, lam_init);
 }
            else {
 attn_unit<true>(A, l, bh >> 2, bh & 3, grp == 1 ? 2 * level + 1 : 2 * level, lds, lam, lam_init);
 }
        } else if (it < 256 + MIX_GMLP_ITEMS) {
 gmlp_unit(A, l, it - 256, lds);
 }
        else {
 conv_unit(A, l, it - 256 - MIX_GMLP_ITEMS, lds);
 }
        if (tid == 0) *slot = nxt;
    }
}

__global__ void __launch_bounds__(512, 2) fwd_kernel(Args A_unused) {
    CA* const P0 = (CA*)__builtin_amdgcn_kernarg_segment_ptr();
    extern __shared__ __attribute__((aligned(16))) unsigned char lds_raw[];
    LAS unsigned char* lds = (LAS unsigned char*)lds_raw;
    cg::grid_group grid = cg::this_grid();
    const int ph_lo = P0->ph_lo, ph_hi = P0->ph_hi;
    if (threadIdx.x < 16) ((LAS unsigned*)(lds + LDS_MAIN))[threadIdx.x] = 0u;
    __syncthreads();
    XcdBarrier xbar = xcd_barrier_post((unsigned*)(P0->ws + WS_XBAR), (volatile LAS unsigned*)(lds + LDS_MAIN + 16));
    for (int ph = ph_lo; ph < ph_hi; ++ph) {
        CA* P = P0; asm volatile("" : "+s"(P)); CA& A = *P;
        bf16_t* XN = (bf16_t*)(A.ws + WS_XN); bf16_t* ACT = (bf16_t*)(A.ws + WS_ACT); bf16_t* Zp = (bf16_t*)(A.ws + WS_Z); bf16_t* MIXp = (bf16_t*)(A.ws + WS_MIX);
        const float* MOD = (const float*)(A.ws + WS_MOD);
        if (ph == 0) { p0_prologue(A, lds); }
        else if (ph == 1) { p1_phase(A); }
        else {
            int l = (ph - 2) / 7, s = (ph - 2) % 7;
            asm volatile("" : "+s"(l), "+s"(s));
            if (s == 3) { cum_scan(A, l, lds); mix_phase(A, l, lds); }
            else {
                const bf16_t* Ap; const bf16_t* Bt; int N, K; EpiAll E{(const void*)P0, l, s};
                if (s == 0 || s == 5) { Ap = XN; Bt = (const bf16_t*)(A.ws + (s == 0 ? WS_W1IN : WS_W2IN)) + (size_t)l * 2 * DFF * DM; N = 2 * DFF; K = DM; }
                else if (s == 2) { Ap = XN; Bt = (const bf16_t*)(A.ws + WS_WIN) + (size_t)l * ZN * DM; N = ZN; K = DM; }
                else { Ap = (s == 4) ? MIXp : ACT;
                    Bt = (s == 4) ? (const bf16_t*)(A.ws + WS_WOUT) + (size_t)l * DM * DM : (const bf16_t*)(A.ws + (s == 1 ? WS_W1OUT : WS_W2OUT)) + (size_t)l * DM * DFF;
                    N = DM; K = (s == 4) ? DM : DFF; }
                pg8::Gemm g{Ap, Bt, M, N, K}; pg8::StaticOrder S; S.init(M, N, (int)gridDim.x, (int)blockIdx.x);
                pg8::gemm_phase<EpiAll, pg8::StaticOrder, true, true>(lds, g, S, E);
                if (s == 1 || s == 4 || s == 6) fused_norm_tail(A, l, s);
                if (gridDim.x == 256) {
                    constexpr int R_F1OUT = 2 * I_FIN, R_F2OUT = R_F1OUT + I_FOUT, R_WIN = R_F2OUT + I_FOUT, R_WOUT = R_WIN + I_WIN;
                    const int wvx = (int)__builtin_amdgcn_readfirstlane(threadIdx.x >> 6);
                    if ((s == 0 || s == 5) && blockIdx.x >= 128) {
                        const int wv_ = (int)(blockIdx.x - 128) * 8 + wvx;
                        if (l == 0 && s == 0) weight_copies(A, lds, I_LAYER, I_LAYER + I_FIN, wv_, 128 * 8);
                        if (l == 0 && s == 5) { weight_copies(A, lds, I_LAYER + R_F1OUT, I_LAYER + R_F2OUT, wv_, 128 * 8);
                                                weight_copies(A, lds, I_LAYER + R_WIN, I_LAYER + R_WOUT, wv_, 128 * 8); }
                        if (l == 1 && s == 0) weight_copies(A, lds, I_LAYER + I_FIN, I_LAYER + 2 * I_FIN, wv_, 128 * 8);
                    } else if (l == 1 && s == 2 && blockIdx.x >= 192) {
                        const int wv_ = (int)(blockIdx.x - 192) * 8 + wvx;
                        weight_copies(A, lds, I_LAYER + R_F2OUT, I_LAYER + R_WIN, wv_, 64 * 8);
                        weight_copies(A, lds, I_LAYER + R_WOUT, 2 * I_LAYER, wv_, 64 * 8);
                    }
                }
            }
        }
        if (ph + 1 < ph_hi) {
            if (ph_lo < 0) grid.sync();
            xcd_barrier(xbar);
        }
    }
}

extern "C" void kernel_launch(void* const* d_in, const int* in_sizes, int n_in, void* d_out, int out_size, void* d_ws, size_t ws_size, hipStream_t stream) {
    static int grid_blocks = 0;
    if (grid_blocks == 0) {
        if (n_in != 24 || out_size != M * DM || ws_size < WS_END) { fprintf(stderr, "kernel_launch: unexpected problem (n_in %d out %d ws %zu)\n", n_in, out_size, ws_size); grid_blocks = -1; return; }
        int dev = 0, cus = 0, per_cu = 0;
        hipGetDevice(&dev);
        hipDeviceGetAttribute(&cus, hipDeviceAttributeMultiprocessorCount, dev);
        hipFuncSetAttribute((const void*)fwd_kernel, hipFuncAttributeMaxDynamicSharedMemorySize, LDS_BYTES);
        hipOccupancyMaxActiveBlocksPerMultiprocessor(&per_cu, (const void*)fwd_kernel, 512, LDS_BYTES);
        if (per_cu < 1) { fprintf(stderr, "kernel_launch: occupancy query says %d blocks per CU\n", per_cu); per_cu = 1; }
        (void)hipGetLastError();
        grid_blocks = cus;
    }
    if (grid_blocks < 0) return;
    hipMemsetAsync((char*)d_ws + WS_CTL, 0, CTL_BYTES, stream);
    hipMemsetAsync((char*)d_ws + WS_MOD, 0, (size_t)DEPTH * 4 * NMODC * sizeof(float), stream);
    Args a{};
    const float** ap = (const float**)&a;
    for (int i = 0; i < 24; ++i) ap[i] = (const float*)d_in[i];
    a.out = (float*)d_out; a.ws = (unsigned char*)d_ws;
#if MK_ONE_LAUNCH
    a.ph_lo = 0; a.ph_hi = NPHASE;
    void* args[] = {&a};
    hipError_t e = hipLaunchCooperativeKernel((const void*)fwd_kernel, dim3(grid_blocks), dim3(512), args, LDS_BYTES, stream);
    if (e != hipSuccess) fprintf(stderr, "cooperative launch failed: %s (grid %d)\n", hipGetErrorString(e), grid_blocks);
#else
    for (int ph = 0; ph < NPHASE; ++ph) { a.ph_lo = ph; a.ph_hi = ph + 1; hipLaunchKernelGGL(fwd_kernel, dim3(grid_blocks), dim3(512), LDS_BYTES, stream, a); }
#endif
}
```

```cpp
#include <hip/hip_runtime.h>
#include <hip/hip_cooperative_groups.h>
#include <cstdio>
#include <cstdint>
namespace cg = cooperative_groups;
namespace pg8 {
#define PG8_LAS __attribute__((address_space(3)))
typedef unsigned short bf16_t;
typedef short bf16x8 __attribute__((ext_vector_type(8)));
typedef float f32x4 __attribute__((ext_vector_type(4)));
typedef unsigned u32x4 __attribute__((ext_vector_type(4)));
constexpr int BM = 256, BK = 64, HALF = 128, HTB = HALF * BK * 2  , STAGE_BYTES = 8 * HTB, NXCD = 8, WGM = 8;

__host__ __device__ __forceinline__ int lds_byte(int r, int c) { const int st = (r >> 4) * 2 + (c >> 5), rr = r & 15, cc = c & 31, ob = rr * 64 + cc * 2; return st * 1024 + (ob ^ (((ob >> 9) & 1) << 5)); }
__host__ __device__ __forceinline__ void stage_rc(int b, int& R, int& C) { const int st = b / 1024, sb = b % 1024, swz = sb ^ (((sb >> 9) & 1) << 5); R = (st >> 1) * 16 + swz / 64; C = (st & 1) * 32 + (swz % 64) / 2; }
__host__ __device__ __forceinline__ int perm32(int rho) { const int n = rho >> 4, i = rho & 15; return 8 * (i >> 2) + 4 * n + (i & 3); }

struct Unit { int pm, pn; };
struct Gemm { const bf16_t* A; const bf16_t* Bt; int M, N, K; };

struct StaticOrder {
    int nM, nN, nwg, G, c;
    __host__ __device__ void init(int M, int N, int G_, int c_) { nM = M / BM; nN = N / BM; nwg = nM * nN; G = G_; c = c_; }
    __host__ __device__ bool next(int i, Unit& u) const {
        const long L = (long)i * G + c; if (L >= nwg) return false;
        int wgid = (int)L; { const int q = nwg / NXCD, r = nwg % NXCD, xcd = wgid % NXCD, off = wgid / NXCD; wgid = (xcd < r ? xcd * (q + 1) : r * (q + 1) + (xcd - r) * q) + off; }
        const int nig = WGM * nN, gid = wgid / nig, fm = gid * WGM, gsz = (nM - fm) < WGM ? (nM - fm) : WGM;
        u.pm = fm + ((wgid % nig) % gsz); u.pn = (wgid % nig) / gsz; return true;
    }
    __device__ __forceinline__ void a_ready(const Unit&) const {}
    __device__ __forceinline__ void done(const Unit&) const {}
};

__device__ __forceinline__ unsigned cvt_pk_bf16(float lo, float hi) { unsigned r; asm volatile("v_cvt_pk_bf16_f32 %0, %1, %2" : "=v"(r) : "v"(lo), "v"(hi)); return r; }
typedef float f32x2 __attribute__((ext_vector_type(2)));
template <class Epi, class Sched, bool ALIGN_EPI = false, bool SP2 = false>
__device__ __forceinline__ void gemm_phase(PG8_LAS unsigned char* lds, const Gemm g, const Sched& S, const Epi& E) {
    int tid = (int)threadIdx.x; asm volatile("" : "+v"(tid)); const int wid = __builtin_amdgcn_readfirstlane(tid >> 6), lane = tid & 63, wr = wid >> 2, wc = wid & 3, fr = lane & 15, fq = lane >> 4;
    const int K = g.K, nt = K / BK;
    unsigned voffA[2], voffB[2];
#pragma unroll
    for (int i = 0; i < 2; ++i) { int R, C; stage_rc(tid * 16 + i * 8192, R, C); const int Rb = Epi::PERM ? ((R & ~31) + perm32(R & 31)) : R;
        voffA[i] = (unsigned)(R * K + C) * 2u; voffB[i] = (unsigned)(Rb * K + C) * 2u; }
    const size_t kstep = (size_t)(BK * 2);
    const size_t hstep = (size_t)HALF * K * 2;
    const size_t tstep = 2 * hstep;
    const unsigned ldsw = (unsigned)wid * 1024u;
    const int aoff = lds_byte(wr * 64 + fr, fq * 8), boff = lds_byte(wc * 32 + fr, fq * 8);
#define PG8_SA(b, h) (((b) * 2 + (h)) * HTB)
#define PG8_SB(b, h) ((4 + (b) * 2 + (h)) * HTB)
#define PG8_STAGE(bufoff, gbase, voff) do { _Pragma("unroll") for (int _i = 0; _i < 2; ++_i) \
        __builtin_amdgcn_global_load_lds((const unsigned*)((const char*)(gbase) + (voff)[_i]), (PG8_LAS unsigned*)(lds + (bufoff) + ldsw + _i * 8192), 16, 0, 0); } while (0)
#define PG8_LDA(dst, b, h) do { _Pragma("unroll") for (int m = 0; m < 4; ++m) _Pragma("unroll") for (int k = 0; k < 2; ++k) dst[m][k] = *(const PG8_LAS bf16x8*)(lds + PG8_SA(b, h) + aoff + m * 2048 + k * 1024); } while (0)
#define PG8_LDB(dst, b, h) do { _Pragma("unroll") for (int n = 0; n < 2; ++n) _Pragma("unroll") for (int k = 0; k < 2; ++k) dst[n][k] = *(const PG8_LAS bf16x8*)(lds + PG8_SB(b, h) + boff + n * 2048 + k * 1024); } while (0)
#define PG8_MMA(ai, bj, At, Bt) do { __builtin_amdgcn_s_setprio(1); _Pragma("unroll") for (int m = 0; m < 4; ++m) _Pragma("unroll") for (int n = 0; n < 2; ++n) _Pragma("unroll") for (int k = 0; k < 2; ++k) \
        acc[ai][bj][m][n] = __builtin_amdgcn_mfma_f32_16x16x32_bf16(Bt[n][k], At[m][k], acc[ai][bj][m][n], 0, 0, 0); __builtin_amdgcn_s_setprio(0); } while (0)
#define PG8_WAIT_V(n) asm volatile("s_waitcnt vmcnt(" #n ")" ::: "memory")
#define PG8_WAIT_L(n) asm volatile("s_waitcnt lgkmcnt(" #n ")" ::: "memory")
#define PG8_BAR __builtin_amdgcn_s_barrier()
#define PG8_SCHED __builtin_amdgcn_sched_barrier(0)
    Unit cur, nxt; int ui = 0;
    if (!S.next(0, cur)) return;
    f32x4 acc[2][2][4][2];
#pragma unroll
    for (int a = 0; a < 2; ++a)
#pragma unroll
        for (int b = 0; b < 2; ++b)
#pragma unroll
            for (int m = 0; m < 4; ++m)
#pragma unroll
                for (int n = 0; n < 2; ++n) acc[a][b][m][n] = (f32x4){0.f, 0.f, 0.f, 0.f};
    bf16x8 At[4][2], B0[2][2], B1[2][2];
    const char* cA = (const char*)g.A + (size_t)cur.pm * tstep; const char* cB = (const char*)g.Bt + (size_t)cur.pn * tstep;
    S.a_ready(cur);
    if constexpr (SP2) {
        PG8_STAGE(PG8_SB(0, 0), cB, voffB); PG8_STAGE(PG8_SB(0, 1), cB + hstep, voffB); PG8_STAGE(PG8_SA(0, 0), cA, voffA); PG8_STAGE(PG8_SA(0, 1), cA + hstep, voffA);
        if (wr == 1) PG8_BAR;
        PG8_WAIT_V(2); PG8_BAR;
        PG8_STAGE(PG8_SB(1, 0), cB + kstep, voffB); PG8_STAGE(PG8_SA(1, 0), cA + kstep, voffA); PG8_STAGE(PG8_SB(1, 1), cB + hstep + kstep, voffB);
        PG8_WAIT_V(6); PG8_BAR;
    } else {
        PG8_STAGE(PG8_SB(0, 0), cB, voffB); PG8_STAGE(PG8_SA(0, 0), cA, voffA); PG8_STAGE(PG8_SB(0, 1), cB + hstep, voffB); PG8_STAGE(PG8_SA(0, 1), cA + hstep, voffA);
        if (wr == 1) PG8_BAR;
        PG8_WAIT_V(4); PG8_BAR;
        PG8_STAGE(PG8_SB(1, 0), cB + kstep, voffB); PG8_STAGE(PG8_SA(1, 0), cA + kstep, voffA); PG8_STAGE(PG8_SB(1, 1), cB + hstep + kstep, voffB);
        PG8_WAIT_V(6); PG8_BAR;
    }
    for (;;) {
        const bool has_next = S.next(ui + 1, nxt);
        const char* nA = has_next ? (const char*)g.A + (size_t)nxt.pm * tstep : cA; const char* nB = has_next ? (const char*)g.Bt + (size_t)nxt.pn * tstep : cB;
        for (int t = 0; t < nt; t += 2) {
            const bool last = (t == nt - 2);
            const char* a1 = cA + (size_t)(t + 1) * kstep;
            const char* a2 = last ? nA : cA + (size_t)(t + 2) * kstep; const char* b2 = last ? nB : cB + (size_t)(t + 2) * kstep;
            const char* a3 = a2 + kstep; const char* b3 = b2 + kstep;
            if (last && has_next) S.a_ready(nxt);
            if constexpr (SP2) {
            PG8_LDB(B0, 0, 0); PG8_LDB(B1, 0, 1); PG8_SCHED; PG8_LDA(At, 0, 0); PG8_STAGE(PG8_SA(1, 1), a1 + hstep, voffA);
            PG8_WAIT_V(8); PG8_WAIT_L(0); PG8_BAR; PG8_MMA(0, 0, At, B0); PG8_MMA(0, 1, At, B1); PG8_BAR; PG8_SCHED;
            PG8_LDA(At, 0, 1); PG8_STAGE(PG8_SB(0, 0), b2, voffB); PG8_STAGE(PG8_SB(0, 1), b2 + hstep, voffB); PG8_STAGE(PG8_SA(0, 0), a2, voffA);
            PG8_WAIT_V(8); PG8_WAIT_L(0); PG8_BAR; PG8_MMA(1, 0, At, B0); PG8_MMA(1, 1, At, B1); PG8_BAR; PG8_SCHED;
            PG8_LDB(B0, 1, 0); PG8_LDB(B1, 1, 1); PG8_SCHED; PG8_LDA(At, 1, 0); PG8_STAGE(PG8_SA(0, 1), a2 + hstep, voffA);
            PG8_WAIT_V(8); PG8_WAIT_L(0); PG8_BAR; PG8_MMA(0, 0, At, B0); PG8_MMA(0, 1, At, B1); PG8_BAR; PG8_SCHED;
            PG8_LDA(At, 1, 1); PG8_STAGE(PG8_SB(1, 0), b3, voffB); PG8_STAGE(PG8_SB(1, 1), b3 + hstep, voffB); PG8_STAGE(PG8_SA(1, 0), a3, voffA);
            PG8_WAIT_V(8); PG8_WAIT_L(0); PG8_BAR; PG8_MMA(1, 0, At, B0); PG8_MMA(1, 1, At, B1); PG8_BAR; PG8_SCHED;
            } else {
            PG8_LDB(B0, 0, 0); PG8_SCHED; PG8_LDA(At, 0, 0); PG8_STAGE(PG8_SA(1, 1), a1 + hstep, voffA);
            PG8_WAIT_L(8); PG8_BAR; PG8_WAIT_L(0); PG8_MMA(0, 0, At, B0); PG8_BAR; PG8_SCHED;
            PG8_LDB(B1, 0, 1); PG8_STAGE(PG8_SB(0, 0), b2, voffB);
            PG8_BAR; PG8_WAIT_L(0); PG8_MMA(0, 1, At, B1); PG8_BAR;
            PG8_LDA(At, 0, 1); PG8_STAGE(PG8_SA(0, 0), a2, voffA);
            PG8_BAR; PG8_WAIT_L(0); PG8_MMA(1, 0, At, B0); PG8_BAR; PG8_SCHED;
            PG8_STAGE(PG8_SB(0, 1), b2 + hstep, voffB);
            PG8_WAIT_V(6); PG8_BAR; PG8_MMA(1, 1, At, B1); PG8_BAR;
            PG8_LDB(B0, 1, 0); PG8_SCHED; PG8_LDA(At, 1, 0); PG8_STAGE(PG8_SA(0, 1), a2 + hstep, voffA);
            PG8_WAIT_L(8); PG8_BAR; PG8_WAIT_L(0); PG8_MMA(0, 0, At, B0); PG8_BAR; PG8_SCHED;
            PG8_LDB(B1, 1, 1); PG8_STAGE(PG8_SB(1, 0), b3, voffB);
            PG8_BAR; PG8_WAIT_L(0); PG8_MMA(0, 1, At, B1); PG8_BAR;
            PG8_LDA(At, 1, 1); PG8_STAGE(PG8_SA(1, 0), a3, voffA);
            PG8_BAR; PG8_WAIT_L(0); PG8_MMA(1, 0, At, B0); PG8_BAR; PG8_SCHED;
            PG8_STAGE(PG8_SB(1, 1), b3 + hstep, voffB);
            PG8_WAIT_V(6); PG8_BAR; PG8_MMA(1, 1, At, B1); PG8_BAR;
            }
        }
        if constexpr (ALIGN_EPI) { if (wr == 0) PG8_BAR; }
        if constexpr (!Epi::AFTER_DRAIN) { E(acc, cur, wr, wc, fr, fq); S.done(cur); }
        if (!has_next) break;
#pragma unroll
        for (int a = 0; a < 2; ++a)
#pragma unroll
            for (int b = 0; b < 2; ++b)
#pragma unroll
                for (int m = 0; m < 4; ++m)
#pragma unroll
                    for (int n = 0; n < 2; ++n) acc[a][b][m][n] = (f32x4){0.f, 0.f, 0.f, 0.f};
        cur = nxt; cA = nA; cB = nB; ++ui;
        if constexpr (ALIGN_EPI) { if (wr == 1) PG8_BAR; }
    }
    PG8_WAIT_V(0);
    if constexpr (!ALIGN_EPI) { if (wr == 0) PG8_BAR; }
    PG8_BAR;
    if constexpr (Epi::AFTER_DRAIN) { E.fused(acc, cur, wr, wc, fr, fq, lds, wid, lane); S.done(cur); }
#undef PG8_SA
#undef PG8_SB
#undef PG8_STAGE
#undef PG8_LDA
#undef PG8_LDB
#undef PG8_MMA
#undef PG8_WAIT_V
#undef PG8_WAIT_L
#undef PG8_BAR
#undef PG8_SCHED
}
}

#ifndef MK_ONE_LAUNCH
#define MK_ONE_LAUNCH 1
#endif
#define LAS __attribute__((address_space(3)))
typedef unsigned short bf16_t;
typedef unsigned v4u __attribute__((ext_vector_type(4)));
typedef unsigned v2u __attribute__((ext_vector_type(2)));
typedef float f32x4 __attribute__((ext_vector_type(4)));
typedef float f32x16 __attribute__((ext_vector_type(16)));
typedef short bf16x8 __attribute__((ext_vector_type(8)));
typedef short s16x4 __attribute__((ext_vector_type(4)));

constexpr int DM = 1024, BATCH = 4, SEQ = 4096, DEPTH = 2, M = BATCH * SEQ;
constexpr int DFF = 2816, NMODC = 9 * DM;
constexpr int INC = 2564, ZC = 2560;
constexpr int DIFF_Q0 = 0, DIFF_K0 = 256, DIFF_V0 = 512, CONV0 = 768, GMLP0 = 1280, FOX_Q0 = 1792, FOX_K0 = 2048, FOX_V0 = 2304;
constexpr float EPS = 1e-6f;
constexpr float LOG2E = 1.4426950408889634f;
constexpr int NPHASE = 2 + 7 * DEPTH;
constexpr int ZN = 2816;

constexpr size_t MiB = 1u << 20;
constexpr size_t WS_CTL = 0, CTL_BYTES = 65536, WS_XBAR = 16384, WS_PCNT = 32768;
constexpr size_t WS_MOD = 1 * MiB, WS_LOGF = 2 * MiB, WS_NEGC = 2 * MiB + 512 * 1024;
constexpr size_t WS_W1IN = 4 * MiB, WS_W1OUT = 26 * MiB, WS_W2IN = 37 * MiB, WS_W2OUT = 59 * MiB, WS_WIN = 70 * MiB, WS_WOUT = 81 * MiB;
constexpr size_t WS_XN = 85 * MiB, WS_MIX = 117 * MiB, WS_ACT = 149 * MiB, WS_Z = WS_ACT, WS_RSP = 237 * MiB, WS_END = 244 * MiB;
constexpr int LDS_MAIN = 131072, LDS_BYTES = LDS_MAIN + 1024;

struct Args {
    const float *x, *c, *ada_w, *ada_b, *norm_g, *ffn1_w_in, *ffn1_w_out, *ffn2_w_in, *ffn2_w_out, *w_in, *w_out,
        *diff_qk_g, *diff_lambda, *diff_out_g, *conv_w, *conv_b, *conv_norm_g, *conv_norm_b, *gmlp_norm_g, *gmlp_norm_b,
        *gmlp_ws, *gmlp_bs, *fox_qk_g, *fox_fb;
    float* out; unsigned char* ws; int ph_lo, ph_hi;
};

__device__ __forceinline__ int otid() { int t = (int)threadIdx.x; asm volatile("" : "+v"(t)); return t; }
__device__ __forceinline__ float shx(float v, int o) { const int idx = (((int)otid() & 63) ^ o) << 2; return __builtin_bit_cast(float, __builtin_amdgcn_ds_bpermute(idx, __builtin_bit_cast(int, v))); }
typedef const __attribute__((address_space(4))) Args CA;
#define LDS_WAIT() asm volatile("s_waitcnt lgkmcnt(0)" ::: "memory")
__device__ __forceinline__ unsigned f2bf(float f) { unsigned u = __builtin_bit_cast(unsigned, f); return (u + 0x7fffu + ((u >> 16) & 1u)) >> 16; }
typedef float f32x2_t __attribute__((ext_vector_type(2))); typedef __bf16 bf16x2_t __attribute__((ext_vector_type(2)));
__device__ __forceinline__ unsigned pk2(float lo, float hi) { f32x2_t v = {lo, hi}; bf16x2_t b = __builtin_convertvector(v, bf16x2_t); return __builtin_bit_cast(unsigned, b); }
__device__ __forceinline__ float bflo(unsigned w) { return __uint_as_float(w << 16); }
__device__ __forceinline__ float bfhi(unsigned w) { return __uint_as_float(w & 0xffff0000u); }
__device__ __forceinline__ float bf2f(bf16_t b) { return __uint_as_float((unsigned)b << 16); }
__device__ __forceinline__ float wave_sum(float v) {
#pragma unroll
    for (int o = 1; o < 64; o <<= 1) v += shx(v, o);
    return v;
}
__device__ __forceinline__ float fast_sigmoid(float x) { return __builtin_amdgcn_rcpf(1.0f + __builtin_amdgcn_exp2f(-x * LOG2E)); }
__device__ __forceinline__ float gelu_tanh(float x) { const float u = 0.7978845608028654f * (x + 0.044715f * x * x * x); return x * fast_sigmoid(2.0f * u); }
__device__ __forceinline__ int crow(int r, int hi) { return (r & 3) + 8 * (r >> 2) + 4 * hi; }


__device__ __forceinline__ void grid_barrier(unsigned* ctr, unsigned target) {
    asm volatile("s_waitcnt vmcnt(0) lgkmcnt(0)" ::: "memory");
    __syncthreads();
    if (threadIdx.x == 0) {
        __builtin_amdgcn_fence(__ATOMIC_RELEASE, "agent");
        asm volatile("s_waitcnt vmcnt(0)" ::: "memory");
        __hip_atomic_fetch_add(ctr, 1u, __ATOMIC_RELAXED, __HIP_MEMORY_SCOPE_AGENT);
        unsigned spins = 0;
        while (__hip_atomic_load(ctr, __ATOMIC_RELAXED, __HIP_MEMORY_SCOPE_AGENT) < target) { __builtin_amdgcn_s_sleep(1); if (++spins > (1u << 24)) break; }
        __builtin_amdgcn_fence(__ATOMIC_ACQUIRE, "agent");
        asm volatile("s_waitcnt vmcnt(0)" ::: "memory");
    }
    __syncthreads();
}

#define XB_TMO      128
#define XB_XCNT(j)  (256  + 64 * (j))
#define XB_XSUB(j)  (1280 + 64 * (j))
#define XB_XGEN(j)  (2304 + 64 * (j))
#define XB_TOP      3328
#define XB_TOPGEN   3392
#define XCD_BAR_WORDS 3456
#define XB_SPIN_CAP (1u << 18)

__device__ __forceinline__ unsigned xb_ld(unsigned* p)              { return __hip_atomic_load(p, __ATOMIC_RELAXED, __HIP_MEMORY_SCOPE_AGENT); }
__device__ __forceinline__ unsigned xb_add(unsigned* p, unsigned v) { return __hip_atomic_fetch_add(p, v, __ATOMIC_RELAXED, __HIP_MEMORY_SCOPE_AGENT); }
__device__ __forceinline__ unsigned xb_xcc_id() { return (unsigned)__builtin_amdgcn_s_getreg((3 << 11) | 20) & 0xFu; }
#define XB_SPIN(cond, bar) do { unsigned _sp = 0; while (cond) { __builtin_amdgcn_s_sleep(1); \
    if ((++_sp & 255u) == 0u) { if (xb_ld(&(bar)[XB_TMO])) break; if (_sp > XB_SPIN_CAP) { atomicAdd(&(bar)[XB_TMO], 1u); break; } } } } while (0)

struct XcdBarrier {
    unsigned* bar; unsigned x;
    volatile LAS unsigned* st;
};

__device__ __forceinline__ XcdBarrier xcd_barrier_post(unsigned* bar, volatile LAS unsigned* st) {
    XcdBarrier b; b.bar = bar; b.x = xb_xcc_id(); b.st = st;
    if (threadIdx.x == 0) (void)xb_add(&bar[XB_XCNT(b.x)], 1u);
    return b;
}
__device__ __forceinline__ void xcd_barrier_complete(unsigned* bar, unsigned x, unsigned& nloc, unsigned& nx) {
    const unsigned G = gridDim.x * gridDim.y * gridDim.z;
    unsigned sum, cnt, mine, sp = 0u;
    for (;;) {
        sum = 0u; cnt = 0u; mine = 0u;
#pragma unroll
        for (unsigned j = 0; j < 16; ++j) { const unsigned c = xb_ld(&bar[XB_XCNT(j)]); sum += c; cnt += (c > 0u) ? 1u : 0u; mine = (j == x) ? c : mine; }
        if (sum == G) break;
        __builtin_amdgcn_s_sleep(1);
        if ((++sp & 255u) == 0u) { if (xb_ld(&bar[XB_TMO])) break; if (sp > XB_SPIN_CAP) { atomicAdd(&bar[XB_TMO], 1u); break; } }
    }
    nloc = mine > 0u ? mine : 1u; nx = cnt > 0u ? cnt : 1u;
}

__device__ __forceinline__ void xcd_barrier(const XcdBarrier& b) {
    asm volatile("s_waitcnt vmcnt(0)" ::: "memory");
    __syncthreads();
    if (threadIdx.x == 0) {
        unsigned* bar = b.bar;
        __builtin_amdgcn_s_waitcnt(0);
        unsigned nloc = b.st[0], nx = b.st[1];
        if (nloc == 0u) { xcd_barrier_complete(bar, b.x, nloc, nx); b.st[0] = nloc; b.st[1] = nx; }
        const unsigned old = xb_add(&bar[XB_XSUB(b.x)], 1u);
        const unsigned gen = old / nloc;
        if (old + 1u == (gen + 1u) * nloc) {
            __builtin_amdgcn_fence(__ATOMIC_RELEASE, "agent");
            asm volatile("s_waitcnt vmcnt(0)" ::: "memory");
            const unsigned og = xb_add(&bar[XB_TOP], 1u);
            const unsigned tg = og / nx;
            if (og + 1u == (tg + 1u) * nx) xb_add(&bar[XB_TOPGEN], 1u);
            else XB_SPIN(xb_ld(&bar[XB_TOPGEN]) == tg, bar);
            __builtin_amdgcn_fence(__ATOMIC_ACQUIRE, "agent");
            xb_add(&bar[XB_XGEN(b.x)], 1u);
            asm volatile("s_waitcnt vmcnt(0)" ::: "memory");
        } else {
            XB_SPIN(xb_ld(&bar[XB_XGEN(b.x)]) == gen, bar);
            __builtin_amdgcn_fence(__ATOMIC_ACQUIRE, "agent");
            asm volatile("s_waitcnt vmcnt(0)" ::: "memory");
        }
    }
    __syncthreads();
}

struct EpiAll {
    static constexpr bool PERM = true, AFTER_DRAIN = false;
    const void* Pk; int l, s;
    __device__ __forceinline__ void operator()(const f32x4 (&acc)[2][2][4][2], const pg8::Unit& u, int wr, int wc, int fr, int fq) const;
};
__device__ __forceinline__ void epi_all_run(const void* Pk_, int l, int s, const f32x4 (&acc)[2][2][4][2], const pg8::Unit& u, int wr, int wc, int fr, int fq);
__device__ __forceinline__ void EpiAll::operator()(const f32x4 (&acc)[2][2][4][2], const pg8::Unit& u, int wr, int wc, int fr, int fq) const { epi_all_run(Pk, l, s, acc, u, wr, wc, fr, fq); }
__device__ __forceinline__ void epi_all_run(const void* Pk_, int l, int s, const f32x4 (&acc)[2][2][4][2], const pg8::Unit& u, int wr, int wc, int fr, int fq) {
        CA* Pl = (CA*)Pk_; asm volatile("" : "+s"(Pl), "+s"(l), "+s"(s)); CA& A = *Pl;
        unsigned char* const ws = A.ws;
        const int row0 = u.pm * 256 + wr * 64 + fr; const int b = u.pm >> 4;
        if (s == 0 || s == 5) {
            bf16_t* O = (bf16_t*)(ws + WS_ACT);
            const int col0 = u.pn * 128 + wc * 32 + 8 * fq;
#pragma unroll
            for (int ai = 0; ai < 2; ++ai)
#pragma unroll
                for (int m = 0; m < 4; ++m) {
                    bf16_t* rowp = O + (size_t)(row0 + ai * 128 + m * 16) * DFF + col0;
                    float r[8];
#pragma unroll
                    for (int n = 0; n < 2; ++n)
#pragma unroll
                        for (int j = 0; j < 4; ++j) { const float g = acc[ai][0][m][n][j], up = acc[ai][1][m][n][j]; r[n * 4 + j] = g * fast_sigmoid(g) * up; }
                    v4u w; w.x = pk2(r[0], r[1]); w.y = pk2(r[2], r[3]); w.z = pk2(r[4], r[5]); w.w = pk2(r[6], r[7]);
                    *(v4u*)rowp = w;
                }
        } else if (s == 2) {
            bf16_t* O = (bf16_t*)(ws + WS_Z);
            const int col0 = u.pn * 256 + wc * 32 + 8 * fq;
            if (u.pn == 0 || u.pn == 1 || u.pn == 7 || u.pn == 8) {
                const bool fox = u.pn >= 7; const int isk = fox ? u.pn - 7 : u.pn;
                const float* gp = fox ? A.fox_qk_g + l * 128 + isk * 64 : A.diff_qk_g + l * 64 + isk * 32;
                const float qs = isk ? 1.0f : (fox ? 0.125f : 0.17677669529663687f) * LOG2E;
                f32x4 g4[2][2];
#pragma unroll
                for (int bj = 0; bj < 2; ++bj)
#pragma unroll
                    for (int n = 0; n < 2; ++n) g4[bj][n] = *(const f32x4*)(gp + (fox ? 32 * bj : 0) + 8 * fq + 4 * n) * qs;
#pragma unroll
                for (int ai = 0; ai < 2; ++ai)
#pragma unroll
                    for (int m = 0; m < 4; ++m) {
                        bf16_t* rowp = O + (size_t)(row0 + ai * 128 + m * 16) * ZC + u.pn * 256 + 8 * fq;
                        float ssb[2];
#pragma unroll
                        for (int bj = 0; bj < 2; ++bj) { const f32x4 v0 = acc[ai][bj][m][0], v1 = acc[ai][bj][m][1];
                            float t = ((v0[0] * v0[0] + v0[1] * v0[1]) + (v0[2] * v0[2] + v0[3] * v0[3])) + ((v1[0] * v1[0] + v1[1] * v1[1]) + (v1[2] * v1[2] + v1[3] * v1[3]));
                            t += shx(t, 16); t += shx(t, 32); ssb[bj] = t; }
#pragma unroll
                        for (int bj = 0; bj < 2; ++bj) {
                            const float rs = fox ? rsqrtf((ssb[0] + ssb[1]) * (1.0f / 64.0f) + EPS) : rsqrtf(ssb[bj] * (1.0f / 32.0f) + EPS);
                            const f32x4 v0 = acc[ai][bj][m][0] * rs * g4[bj][0], v1 = acc[ai][bj][m][1] * rs * g4[bj][1];
                            v4u w; w.x = pk2(v0[0], v0[1]); w.y = pk2(v0[2], v0[3]); w.z = pk2(v1[0], v1[1]); w.w = pk2(v1[2], v1[3]);
                            *(v4u*)(rowp + (fox ? 64 * wc + 32 * bj : 128 * bj + 32 * wc)) = w;
                        }
                    }
            } else if (u.pn < 10) {
#pragma unroll
                for (int ai = 0; ai < 2; ++ai)
#pragma unroll
                    for (int m = 0; m < 4; ++m) {
                        bf16_t* rowp = O + (size_t)(row0 + ai * 128 + m * 16) * ZC + col0;
#pragma unroll
                        for (int bj = 0; bj < 2; ++bj) {
                            const f32x4 v0 = acc[ai][bj][m][0], v1 = acc[ai][bj][m][1];
                            v4u w; w.x = pk2(v0[0], v0[1]); w.y = pk2(v0[2], v0[3]); w.z = pk2(v1[0], v1[1]); w.w = pk2(v1[2], v1[3]);
                            *(v4u*)(rowp + bj * 128) = w;
                        }
                    }
            } else if (wc == 0 && fq == 0) {
                float* logf = (float*)(ws + WS_LOGF);
                const f32x4 fbv = *(const f32x4*)(A.fox_fb + l * 4);
#pragma unroll
                for (int ai = 0; ai < 2; ++ai)
#pragma unroll
                    for (int m = 0; m < 4; ++m) {
                        const int row = row0 + ai * 128 + m * 16;
                        const f32x4 z = acc[ai][0][m][0] + fbv;
                        f32x4 ls;
#pragma unroll
                        for (int j = 0; j < 4; ++j) ls[j] = fminf(z[j], 0.f) - log1pf(expf(-fabsf(z[j])));
                        *(f32x4*)(logf + (size_t)row * 4) = ls;
                    }
            }
        } else {
            const float* MOD = (const float*)(ws + WS_MOD);
            const int gidx = (s == 1) ? 2 : (s == 4 ? 5 : 8);
            const float* base = (l == 0 && s == 1) ? A.x : A.out; float* out = A.out;
            const float* gp = MOD + (size_t)(l * 4 + b) * NMODC + gidx * DM; const float scale = (s == 4) ? 1.0f : 0.5f;
            const int nsite = 3 * l + (s == 1 ? 1 : (s == 4 ? 2 : 3));
            const int col0 = u.pn * 256 + wc * 32 + 8 * fq;
            float* slots = (float*)(ws + WS_RSP) + (size_t)nsite * M * 16;
            f32x4 gv[2][2];
#pragma unroll
            for (int bj = 0; bj < 2; ++bj)
#pragma unroll
                for (int n = 0; n < 2; ++n) gv[bj][n] = *(const f32x4*)(gp + col0 + bj * 128 + n * 4) * scale;
            f32x4 bb[2][2][2];
#pragma unroll
            for (int bj = 0; bj < 2; ++bj)
#pragma unroll
                for (int n = 0; n < 2; ++n) bb[0][bj][n] = *(const f32x4*)(base + (size_t)row0 * DM + col0 + bj * 128 + n * 4);
#pragma unroll
            for (int g = 0; g < 8; ++g) {
                const int ai = g >> 2, m = g & 3, row = row0 + ai * 128 + m * 16;
                if (g < 7) { const int rown = row0 + ((g + 1) >> 2) * 128 + ((g + 1) & 3) * 16;
#pragma unroll
                    for (int bj = 0; bj < 2; ++bj)
#pragma unroll
                        for (int n = 0; n < 2; ++n) bb[(g + 1) & 1][bj][n] = *(const f32x4*)(base + (size_t)rown * DM + col0 + bj * 128 + n * 4); }
                float ss = 0.f;
#pragma unroll
                for (int bj = 0; bj < 2; ++bj)
#pragma unroll
                    for (int n = 0; n < 2; ++n) {
                        const f32x4 h = bb[g & 1][bj][n] + gv[bj][n] * acc[ai][bj][m][n];
                        *(f32x4*)(out + (size_t)row * DM + col0 + bj * 128 + n * 4) = h;
                        ss += (h[0] * h[0] + h[1] * h[1]) + (h[2] * h[2] + h[3] * h[3]);
                    }
                if (nsite < 3 * DEPTH) {
                    ss += shx(ss, 16); ss += shx(ss, 32);
                    if (fq == 0) __hip_atomic_store(slots + ((size_t)u.pn * M + row) * 4 + wc, ss, __ATOMIC_RELAXED, __HIP_MEMORY_SCOPE_AGENT);
                }
            }
        }
}

__device__ __forceinline__ void fused_norm_tail(CA& A, int l, int s) {
    const int nsite = 3 * l + (s == 1 ? 1 : (s == 4 ? 2 : 3));
    if (nsite >= 3 * DEPTH) return;
    const int tid = otid(), lane = tid & 63, wave = __builtin_amdgcn_readfirstlane(tid >> 6);
    pg8::StaticOrder S; S.init(M, DM, (int)gridDim.x, (int)blockIdx.x); pg8::Unit u;
    if (!S.next(0, u)) return;
    unsigned char* const ws = A.ws;
    const int nl = nsite / 3, nw = nsite % 3, b = u.pm >> 4;
    const float* slots = (const float*)(ws + WS_RSP) + (size_t)nsite * M * 16;
    unsigned* cnt = (unsigned*)(ws + WS_PCNT) + ((size_t)nsite * 64 + u.pm) * 16;
    asm volatile("s_waitcnt vmcnt(0)" ::: "memory");
    __syncthreads();
    const float* MODn = (const float*)(ws + WS_MOD) + (size_t)(nl * 4 + b) * NMODC + (3 * nw) * DM;
    const int col = u.pn * 256 + 4 * lane;
    const float* hbase = A.out; bf16_t* xn = (bf16_t*)(ws + WS_XN);
    f32x4 hrow[32];
#pragma unroll
    for (int r = 0; r < 32; ++r) hrow[r] = *(const f32x4*)(hbase + (size_t)(u.pm * 256 + wave * 32 + r) * DM + col);
    const f32x4 ca = *(const f32x4*)(A.norm_g + (size_t)nsite * DM + col) * (1.0f + *(const f32x4*)(MODn + DM + col)), cb = *(const f32x4*)(MODn + col);
    if (tid == 0) {
        __hip_atomic_fetch_add(cnt, 1u, __ATOMIC_RELAXED, __HIP_MEMORY_SCOPE_AGENT);
        unsigned spins = 0;
        while (__hip_atomic_load(cnt, __ATOMIC_RELAXED, __HIP_MEMORY_SCOPE_AGENT) < 4u) { __builtin_amdgcn_s_sleep(2); if (++spins > (1u << 22)) break; }
    }
    __syncthreads();
    float rstd_l = 0.f;
    {
        const int row = u.pm * 256 + wave * 32 + (lane & 31);
        float ss = 0.f;
#pragma unroll
        for (int t = 0; t < 4; ++t) {
            const unsigned long long* sp = (const unsigned long long*)(slots + ((size_t)t * M + row) * 4);
            const unsigned long long w0 = __hip_atomic_load(sp, __ATOMIC_RELAXED, __HIP_MEMORY_SCOPE_AGENT), w1 = __hip_atomic_load(sp + 1, __ATOMIC_RELAXED, __HIP_MEMORY_SCOPE_AGENT);
            ss += (__uint_as_float((unsigned)w0) + __uint_as_float((unsigned)(w0 >> 32))) + (__uint_as_float((unsigned)w1) + __uint_as_float((unsigned)(w1 >> 32)));
        }
        rstd_l = rsqrtf(ss * (1.0f / DM) + EPS);
    }
#pragma unroll
    for (int r = 0; r < 32; ++r) {
        const int row = u.pm * 256 + wave * 32 + r;
        const float rstd = __builtin_bit_cast(float, __builtin_amdgcn_readlane(__builtin_bit_cast(int, rstd_l), r));
        const f32x4 y = hrow[r] * rstd * ca + cb;
        v2u o; o.x = pk2(y.x, y.y); o.y = pk2(y.z, y.w);
        *(v2u*)(xn + (size_t)row * DM + col) = o;
    }
}

__device__ __forceinline__ void p0_transpose_item(const float* W, int ld, int k0, int n0, bf16_t* WT, int K, int drow0, LAS float* scr, int lane, int ncols) {
    float tv[32];
#pragma unroll
    for (int i = 0; i < 32; ++i) tv[i] = (n0 + (lane & 31) < ncols) ? W[(size_t)(k0 + 2 * i + (lane >> 5)) * ld + n0 + (lane & 31)] : 0.f;
#pragma unroll
    for (int i = 0; i < 32; ++i) scr[(2 * i + (lane >> 5)) * 33 + (lane & 31)] = tv[i];
    LDS_WAIT(); asm volatile("" ::: "memory");
    const int c = lane & 7;
#pragma unroll
    for (int j = 0; j < 4; ++j) { const int n = (lane >> 3) + 8 * j; const LAS float* s = scr + (8 * c) * 33 + n;
        v4u o; o.x = pk2(s[0 * 33], s[1 * 33]); o.y = pk2(s[2 * 33], s[3 * 33]); o.z = pk2(s[4 * 33], s[5 * 33]); o.w = pk2(s[6 * 33], s[7 * 33]);
        *(v4u*)(WT + (size_t)(drow0 + n) * K + k0 + 8 * c) = o; }
    LDS_WAIT(); asm volatile("" ::: "memory");
}
constexpr int I_LAYER_FWD = 2 * (16 * 176 + 44 * 32) + 16 * 88 + 16 * 32;
__device__ __forceinline__ void weight_copies(CA& A, LAS unsigned char* lds, int it_lo, int it_hi, int wi, int nw);
__device__ __forceinline__ void p0_prologue(CA& A, LAS unsigned char* lds) {
    const int tid = otid(), lane = tid & 63, wave = __builtin_amdgcn_readfirstlane(tid >> 6);
    float* MOD = (float*)(A.ws + WS_MOD);
    LAS float* cond = (LAS float*)(lds + 8 * 16384 - 16384);
    for (int i = tid; i < 4 * DM; i += 512) { const float v = A.c[i]; cond[i] = v * fast_sigmoid(v); }
    __syncthreads();
    {
        const int gw0 = blockIdx.x * 8 + wave, NGW0 = gridDim.x * 8;
        for (int it = gw0; it < DEPTH * 144 * 16; it += NGW0) {
            const int kq = it & 15, r = it >> 4, l = r / 144, chunk = r % 144, col = chunk * 64 + lane;
            const float* wp = A.ada_w + (size_t)l * DM * NMODC + (size_t)(kq * 64) * NMODC + col;
            float wv[64];
#pragma unroll
            for (int k = 0; k < 64; ++k) wv[k] = wp[(size_t)k * NMODC];
            float a0 = 0.f, a1 = 0.f, a2 = 0.f, a3 = 0.f;
#pragma unroll
            for (int k = 0; k < 64; ++k) { const int kk = kq * 64 + k; a0 += cond[kk] * wv[k]; a1 += cond[DM + kk] * wv[k]; a2 += cond[2 * DM + kk] * wv[k]; a3 += cond[3 * DM + kk] * wv[k]; }
            if (kq == 0) { const float bb = A.ada_b[(size_t)l * NMODC + col]; a0 += bb; a1 += bb; a2 += bb; a3 += bb; }
            atomicAdd(MOD + (size_t)(l * 4 + 0) * NMODC + col, a0); atomicAdd(MOD + (size_t)(l * 4 + 1) * NMODC + col, a1);
            atomicAdd(MOD + (size_t)(l * 4 + 2) * NMODC + col, a2); atomicAdd(MOD + (size_t)(l * 4 + 3) * NMODC + col, a3);
        }
    }
    __syncthreads();
    weight_copies(A, lds, 0, (gridDim.x == 256) ? I_LAYER_FWD : DEPTH * I_LAYER_FWD, blockIdx.x * 8 + wave, gridDim.x * 8);
}
constexpr int I_FIN = 16 * 176, I_FOUT = 44 * 32, I_WIN = 16 * 88, I_WOUT = 16 * 32, I_LAYER = 2 * (I_FIN + I_FOUT) + I_WIN + I_WOUT;
__device__ __forceinline__ void weight_copies(CA& A, LAS unsigned char* lds, int it_lo, int it_hi, int wi, int nw) {
    const int tid = otid(), lane = tid & 63, wave = __builtin_amdgcn_readfirstlane(tid >> 6);
    LAS float* scr = (LAS float*)(lds + wave * 16384);
    for (int it = it_lo + wi; it < it_hi; it += nw) {
        const int l = it / I_LAYER; int r = it % I_LAYER;
        if (r < 2 * I_FIN) {
            const int which = r / I_FIN; r %= I_FIN; const int kb = r / 176, nb = r % 176, n0 = nb * 32;
            const int up = n0 >= DFF ? 1 : 0, j = n0 - up * DFF, drow0 = (j >> 7) * 256 + up * 128 + (j & 127);
            const float* W = (which ? A.ffn2_w_in : A.ffn1_w_in) + (size_t)l * DM * 2 * DFF;
            bf16_t* WT = (bf16_t*)(A.ws + (which ? WS_W2IN : WS_W1IN)) + (size_t)l * 2 * DFF * DM;
            p0_transpose_item(W, 2 * DFF, kb * 64, n0, WT, DM, drow0, scr, lane, 2 * DFF); continue;
        }
        r -= 2 * I_FIN;
        if (r < 2 * I_FOUT) {
            const int which = r / I_FOUT; r %= I_FOUT; const int kb = r / 32, nb = r % 32;
            const float* W = (which ? A.ffn2_w_out : A.ffn1_w_out) + (size_t)l * DFF * DM;
            bf16_t* WT = (bf16_t*)(A.ws + (which ? WS_W2OUT : WS_W1OUT)) + (size_t)l * DM * DFF;
            p0_transpose_item(W, DM, kb * 64, nb * 32, WT, DFF, nb * 32, scr, lane, DM); continue;
        }
        r -= 2 * I_FOUT;
        if (r < I_WIN) {
            const int kb = r / 88, nb = r % 88; int drow = nb * 32;
            if (nb >= 56 && nb < 72) { const int tile = nb >> 3, k = nb & 7; drow = tile * 256 + 128 * (k & 1) + 32 * (k >> 1); }
            p0_transpose_item(A.w_in + (size_t)l * DM * INC, INC, kb * 64, nb * 32, (bf16_t*)(A.ws + WS_WIN) + (size_t)l * ZN * DM, DM, drow, scr, lane, INC); continue;
        }
        r -= I_WIN;
        { const int kb = r / 32, nb = r % 32;
          p0_transpose_item(A.w_out + (size_t)l * DM * DM, DM, kb * 64, nb * 32, (bf16_t*)(A.ws + WS_WOUT) + (size_t)l * DM * DM, DM, nb * 32, scr, lane, DM); }
    }
}

__device__ __forceinline__ void p1_phase(CA& A) {
    const int tid = otid(), lane = tid & 63, wave = __builtin_amdgcn_readfirstlane(tid >> 6);
    const int gw = blockIdx.x * 8 + wave, NGW = gridDim.x * 8;
    const float* MOD = (const float*)(A.ws + WS_MOD);
    bf16_t* XN = (bf16_t*)(A.ws + WS_XN);
    for (int grp = gw; grp < M / 8; grp += NGW) {
        const int row0 = grp * 8, b = row0 >> 12;
        f32x4 ca[4], cb[4];
#pragma unroll
        for (int j = 0; j < 4; ++j) { const int col = 4 * lane + 256 * j;
            ca[j] = *(const f32x4*)(A.norm_g + col) * (1.0f + *(const f32x4*)(MOD + (size_t)b * NMODC + DM + col)); cb[j] = *(const f32x4*)(MOD + (size_t)b * NMODC + col); }
        for (int r = 0; r < 8; ++r) {
            const size_t row = row0 + r; f32x4 v[4]; float ss = 0.f;
#pragma unroll
            for (int j = 0; j < 4; ++j) { v[j] = *(const f32x4*)(A.x + row * DM + 4 * lane + 256 * j); ss += (v[j].x * v[j].x + v[j].y * v[j].y) + (v[j].z * v[j].z + v[j].w * v[j].w); }
            const float rstd = rsqrtf(wave_sum(ss) * (1.0f / DM) + EPS);
#pragma unroll
            for (int j = 0; j < 4; ++j) { const f32x4 y = v[j] * rstd * ca[j] + cb[j]; v2u o; o.x = pk2(y.x, y.y); o.y = pk2(y.z, y.w);
                *(v2u*)(XN + row * DM + 4 * lane + 256 * j) = o; }
        }
    }
}

__device__ __forceinline__ void cum_scan(CA& A, int l, LAS unsigned char* lds) {
    if (blockIdx.x >= 16) return;
    const int tid = otid(), lane = tid & 63, wave = tid >> 6;
    const int b = blockIdx.x >> 2, hh = blockIdx.x & 3;
    const float* LOGF = (const float*)(A.ws + WS_LOGF);
    float* NEGC = (float*)(A.ws + WS_NEGC);
    LAS float* wt = (LAS float*)lds;
    float v[8]; float run = 0.f;
#pragma unroll
    for (int i = 0; i < 8; ++i) { run += LOGF[((size_t)b * SEQ + tid * 8 + i) * 4 + hh]; v[i] = run; }
    float inc = run;
#pragma unroll
    for (int o = 1; o < 64; o <<= 1) { const float t = __shfl_up(inc, o); if (lane >= o) inc += t; }
    if (lane == 63) wt[wave] = inc;
    __syncthreads();
    float off = inc - run;
    for (int w = 0; w < wave; ++w) off += wt[w];
#pragma unroll
    for (int i = 0; i < 8; ++i) __hip_atomic_store(NEGC + (size_t)(b * 4 + hh) * SEQ + tid * 8 + i, -(v[i] + off) * LOG2E, __ATOMIC_RELAXED, __HIP_MEMORY_SCOPE_AGENT);
    asm volatile("s_waitcnt vmcnt(0)" ::: "memory");
    __syncthreads();
    if (tid == 0) __hip_atomic_store((unsigned*)(A.ws + WS_CTL) + 128 + l * 16 + blockIdx.x, 1u, __ATOMIC_RELAXED, __HIP_MEMORY_SCOPE_AGENT);
}

constexpr int AL_KS = 0, AL_KSZ = 64 * 144, AL_VT = 2 * AL_KSZ, AL_VSZ = 64 * 136, AL_NC = AL_VT + 2 * AL_VSZ, AL_O2 = 36864 + 1024;
static_assert(AL_NC + 1024 <= AL_O2 && AL_O2 + 128 * 65 * 4 <= LDS_MAIN, "attention LDS map");

template <bool DIFF>
__device__ __forceinline__ void attn_unit(CA& A, int l, int b, int hh, int qb, LAS unsigned char* lds, float lam, float lam_init) {
    constexpr int DQK = DIFF ? 32 : 64, NS = DQK / 16, QROWS = DIFF ? 128 : 256;
    const int tid = otid(), lane = tid & 63, wid = __builtin_amdgcn_readfirstlane(tid >> 6), r32 = lane & 31, hi = lane >> 5;
    const int q0 = qb * QROWS, wq = DIFF ? (wid & 3) * 32 : wid * 32, strm = DIFF ? (wid >> 2) : 0;
    const bf16_t* Zb = (const bf16_t*)(A.ws + WS_Z) + (size_t)b * SEQ * ZC;
    bf16_t* MIX = (bf16_t*)(A.ws + WS_MIX);
    const int qcol = DIFF ? (DIFF_Q0 + hh * 64 + strm * 32) : (FOX_Q0 + hh * 64);
    const int kcol = DIFF ? (DIFF_K0 + hh * 64) : (FOX_K0 + hh * 64);
    const int vcol = DIFF ? (DIFF_V0 + hh * 64) : (FOX_V0 + hh * 64);
    const float* gq = DIFF ? A.diff_qk_g + l * 64 : A.fox_qk_g + l * 128;
    const float* gk = gq + DQK;
    const int skey = tid >> 3, sch = tid & 7;
    const bf16_t* kp = Zb + (size_t)skey * ZC + kcol + 8 * sch;
    const bf16_t* vp = Zb + (size_t)lane * ZC + vcol + 8 * wid;
    const float* ncp = (const float*)(A.ws + WS_NEGC) + (size_t)(b * 4 + hh) * SEQ;
    const int NT = (q0 + QROWS) / 64;
    v4u kraw, vraw; float ncv = 0.f;
    v4u qraw[NS];
    {
        const bf16_t* qp = Zb + (size_t)(q0 + wq + r32) * ZC + qcol + 8 * hi;
#pragma unroll
        for (int s = 0; s < NS; ++s) qraw[s] = *(const v4u*)(qp + 16 * s);
    }
    { const int t0_ = DIFF ? 0 : NT - 1; kraw = *(const v4u*)(kp + (size_t)t0_ * 64 * ZC); vraw = *(const v4u*)(vp + (size_t)t0_ * 64 * ZC); }
    const float gkl = gk[lane & (DQK - 1)];
    bf16x8 qf[NS]; float qn2 = 0.f;
#pragma unroll
    for (int s = 0; s < NS; ++s) { qf[s] = __builtin_bit_cast(bf16x8, qraw[s]);
#pragma unroll
        for (int i = 0; i < 4; ++i) qn2 += bflo(qraw[s][i]) * bflo(qraw[s][i]) + bfhi(qraw[s][i]) * bfhi(qraw[s][i]); }
    qn2 += shx(qn2, 32);
    float qkb;
    {
        float gm = fabsf(gkl);
#pragma unroll
        for (int o_ = 1; o_ < 64; o_ <<= 1) gm = fmaxf(gm, shx(gm, o_));
        qkb = sqrtf(qn2) * sqrtf((float)DQK) * gm * 1.02f;
    }
#define ATT_LOAD(t) do { kraw = *(const v4u*)(kp + (size_t)(t) * 64 * ZC); vraw = *(const v4u*)(vp + (size_t)(t) * 64 * ZC); \
        if (!DIFF && tid < 64) ncv = ncp[(t) * 64 + tid]; } while (0)
#define ATT_WRITE(buf) do { *(LAS v4u*)(lds + AL_KS + (buf) * AL_KSZ + skey * 144 + sch * 16) = kraw;     \
        _Pragma("unroll") for (int i = 0; i < 4; ++i) { \
            *(LAS unsigned short*)(lds + AL_VT + (buf) * AL_VSZ + (8 * wid + 2 * i) * 136 + lane * 2) = (unsigned short)(vraw[i] & 0xffffu); \
            *(LAS unsigned short*)(lds + AL_VT + (buf) * AL_VSZ + (8 * wid + 2 * i + 1) * 136 + lane * 2) = (unsigned short)(vraw[i] >> 16); } \
        if (!DIFF && tid < 64) *(LAS float*)(lds + AL_NC + (buf) * 512 + tid * 4) = ncv; } while (0)
    if (!DIFF) {
        if (tid == 0) { const unsigned* fl = (const unsigned*)(A.ws + WS_CTL) + 128 + l * 16 + b * 4 + hh; unsigned spins = 0;
            while (__hip_atomic_load(fl, __ATOMIC_RELAXED, __HIP_MEMORY_SCOPE_AGENT) == 0u) { __builtin_amdgcn_s_sleep(2); if (++spins > (1u << 22)) break; } }
        __syncthreads();
    }
    float ncq = 0.f;
    if (!DIFF) { if (tid < 64) ncv = ncp[(NT - 1) * 64 + tid]; ncq = ncp[q0 + wq + r32]; }
    ATT_WRITE(0);
    __syncthreads();
    f32x16 o[2], ol; float m_ref = 0.f;
#pragma unroll
    for (int r = 0; r < 16; ++r) { o[0][r] = 0.f; o[1][r] = 0.f; ol[r] = 0.f; }
    f32x16 negm;
#pragma unroll
    for (int r = 0; r < 16; ++r) negm[r] = 0.f;
    const bf16x8 ones = {0x3F80, 0x3F80, 0x3F80, 0x3F80, 0x3F80, 0x3F80, 0x3F80, 0x3F80};
    const int qfirst = q0 + wq, qlast = qfirst + 31, qmine = qfirst + r32;
    const int koff = DIFF ? strm * 32 : 0;
    if (DIFF) {
        m_ref = qkb;
#pragma unroll
        for (int r = 0; r < 16; ++r) negm[r] = -qkb;
    } else {
        m_ref = qkb + ncq;
    }
    volatile LAS int* votes = (volatile LAS int*)(lds + LDS_MAIN + 64);
    bool first = true;
    for (int tt = 0; ; ++tt) {
        const int t = DIFF ? tt : NT - 1 - tt;
        const bool has_next = tt + 1 < NT;
        const int buf = tt & 1, key0 = t * 64;
        float nc_hi = 0.f;
        if (has_next) { ATT_LOAD(DIFF ? t + 1 : t - 1); if (!DIFF) nc_hi = ncp[key0 - 1]; }
        if (key0 <= qlast) {
            const LAS unsigned char* Kb = lds + AL_KS + buf * AL_KSZ;
            const LAS unsigned char* Vb = lds + AL_VT + buf * AL_VSZ;
            f32x16 p[2];
#pragma unroll
            for (int kt = 0; kt < 2; ++kt) {
                if (!DIFF) {
                    const LAS float* nc = (const LAS float*)(lds + AL_NC + buf * 512) + 32 * kt + 4 * hi;
#pragma unroll
                    for (int g = 0; g < 4; ++g) { const f32x4 c4 = *(const LAS f32x4*)(nc + 8 * g); p[kt][4 * g] = c4[0]; p[kt][4 * g + 1] = c4[1]; p[kt][4 * g + 2] = c4[2]; p[kt][4 * g + 3] = c4[3]; }
                }
#pragma unroll
                for (int s = 0; s < NS; ++s) {
                    const bf16x8 a = *(const LAS bf16x8*)(Kb + (32 * kt + r32) * 144 + (koff + 16 * s + 8 * hi) * 2);
                    if (DIFF && s == 0) p[kt] = __builtin_amdgcn_mfma_f32_32x32x16_bf16(a, qf[s], negm, 0, 0, 0);
                    else p[kt] = __builtin_amdgcn_mfma_f32_32x32x16_bf16(a, qf[s], p[kt], 0, 0, 0);
                }
            }
            if (!DIFF) {
#pragma unroll
                for (int kt = 0; kt < 2; ++kt)
#pragma unroll
                    for (int r = 0; r < 16; ++r) p[kt][r] -= m_ref;
            }
            if (key0 + 63 > qfirst) {
#pragma unroll
                for (int kt = 0; kt < 2; ++kt)
#pragma unroll
                    for (int r = 0; r < 16; ++r) if (key0 + 32 * kt + crow(r, hi) > qmine) p[kt][r] = -1e30f;
            }
            first = false;
#pragma unroll
            for (int kt = 0; kt < 2; ++kt)
#pragma unroll
                for (int r = 0; r < 16; ++r) p[kt][r] = __builtin_amdgcn_exp2f(p[kt][r]);
            bf16x8 pb[2][2];
#pragma unroll
            for (int kt = 0; kt < 2; ++kt)
#pragma unroll
                for (int i = 0; i < 2; ++i) { v4u w;
#pragma unroll
                    for (int j = 0; j < 4; ++j) w[j] = pk2(p[kt][8 * i + 2 * j], p[kt][8 * i + 2 * j + 1]);
                    pb[kt][i] = __builtin_bit_cast(bf16x8, w); }
#pragma unroll
            for (int kt = 0; kt < 2; ++kt)
#pragma unroll
                for (int i = 0; i < 2; ++i) {
#pragma unroll
                    for (int dt = 0; dt < 2; ++dt) {
                        const LAS unsigned char* vq = Vb + (32 * dt + r32) * 136 + (32 * kt + 16 * i + 4 * hi) * 2;
                        const s16x4 lo = *(const LAS s16x4*)vq, h4 = *(const LAS s16x4*)(vq + 16);
                        const bf16x8 a = {lo[0], lo[1], lo[2], lo[3], h4[0], h4[1], h4[2], h4[3]};
                        o[dt] = __builtin_amdgcn_mfma_f32_32x32x16_bf16(a, pb[kt][i], o[dt], 0, 0, 0);
                    }
                    ol = __builtin_amdgcn_mfma_f32_32x32x16_bf16(ones, pb[kt][i], ol, 0, 0, 0);
                }
        }
        if (has_next) ATT_WRITE(buf ^ 1);
        if (!DIFF) {
            const int vote = (!first && !__any(nc_hi + qkb - m_ref + 2.0f * qkb >= -48.0f)) ? 1 : 0;
            if (lane == 0) votes[(tt & 1) * 8 + wid] = vote;
        }
        __syncthreads();
        if (!has_next) break;
        if (!DIFF) {
            const int pb_ = (tt & 1) * 8;
            const int all = votes[pb_] & votes[pb_ + 1] & votes[pb_ + 2] & votes[pb_ + 3] & votes[pb_ + 4] & votes[pb_ + 5] & votes[pb_ + 6] & votes[pb_ + 7];
            if (all) break;
        }
    }
#undef ATT_LOAD
#undef ATT_WRITE
    const float inv = 1.0f / ol[0];
    const size_t orow = (size_t)b * SEQ + q0 + wq + r32;
    if (!DIFF) {
#pragma unroll
        for (int dt = 0; dt < 2; ++dt)
#pragma unroll
            for (int g = 0; g < 4; ++g) {
                v2u w; w.x = pk2(o[dt][4 * g] * inv, o[dt][4 * g + 1] * inv); w.y = pk2(o[dt][4 * g + 2] * inv, o[dt][4 * g + 3] * inv);
                *(v2u*)(MIX + orow * DM + 768 + hh * 64 + 32 * dt + 8 * g + 4 * hi) = w;
            }
    } else {
        LAS float* O2 = (LAS float*)(lds + AL_O2);
        if (strm == 1) {
#pragma unroll
            for (int dt = 0; dt < 2; ++dt)
#pragma unroll
                for (int r = 0; r < 16; ++r) O2[(wq + r32) * 65 + 32 * dt + crow(r, hi)] = o[dt][r] * inv;
        }
        __syncthreads();
        if (strm == 0) {
            float ss = 0.f;
#pragma unroll
            for (int dt = 0; dt < 2; ++dt)
#pragma unroll
                for (int r = 0; r < 16; ++r) { const float v = o[dt][r] * inv - lam * O2[(wq + r32) * 65 + 32 * dt + crow(r, hi)]; o[dt][r] = v; ss += v * v; }
            ss += shx(ss, 32);
            const float rs = rsqrtf(ss * (1.0f / 64.0f) + EPS) * (1.0f - lam_init);
            const float* og = A.diff_out_g + l * 64;
#pragma unroll
            for (int dt = 0; dt < 2; ++dt)
#pragma unroll
                for (int g = 0; g < 4; ++g) { const int d = 32 * dt + 8 * g + 4 * hi;
                    v2u w; w.x = pk2(o[dt][4 * g] * rs * og[d], o[dt][4 * g + 1] * rs * og[d + 1]); w.y = pk2(o[dt][4 * g + 2] * rs * og[d + 2], o[dt][4 * g + 3] * rs * og[d + 3]);
                    *(v2u*)(MIX + orow * DM + hh * 64 + d) = w; }
        }
    }
}

__device__ __forceinline__ void conv_unit(CA& A, int l, int u, LAS unsigned char* lds) {
    const int tid = otid(), lane = tid & 63, wid = tid >> 6;
    const int b = u >> 6, t0 = (u & 63) * 64;
    const bf16_t* Zb = (const bf16_t*)(A.ws + WS_Z) + (size_t)b * SEQ * ZC;
    bf16_t* MIX = (bf16_t*)(A.ws + WS_MIX);
    LAS float* Y = (LAS float*)lds;
    {
        v4u araw[6], graw[6];
#pragma unroll
        for (int k = 0; k < 6; ++k) { const int idx = tid + 512 * k, r = idx >> 5, ch = idx & 31, t = t0 - 30 + r;
            araw[k] = (v4u){0u, 0u, 0u, 0u}; graw[k] = (v4u){0u, 0u, 0u, 0u};
            if (idx < 94 * 32 && t >= 0) { araw[k] = *(const v4u*)(Zb + (size_t)t * ZC + CONV0 + 8 * ch); graw[k] = *(const v4u*)(Zb + (size_t)t * ZC + CONV0 + 256 + 8 * ch); } }
#pragma unroll
        for (int k = 0; k < 6; ++k) { const int idx = tid + 512 * k, r = idx >> 5, ch = idx & 31;
            if (idx < 94 * 32) {
                const v4u a = araw[k], g = graw[k]; f32x4 y0, y1;
                y0[0] = bflo(a[0]) * fast_sigmoid(bflo(g[0])); y0[1] = bfhi(a[0]) * fast_sigmoid(bfhi(g[0]));
                y0[2] = bflo(a[1]) * fast_sigmoid(bflo(g[1])); y0[3] = bfhi(a[1]) * fast_sigmoid(bfhi(g[1]));
                y1[0] = bflo(a[2]) * fast_sigmoid(bflo(g[2])); y1[1] = bfhi(a[2]) * fast_sigmoid(bfhi(g[2]));
                y1[2] = bflo(a[3]) * fast_sigmoid(bflo(g[3])); y1[3] = bfhi(a[3]) * fast_sigmoid(bfhi(g[3]));
                *(LAS f32x4*)(Y + r * 256 + 8 * ch) = y0; *(LAS f32x4*)(Y + r * 256 + 8 * ch + 4) = y1;
            } }
    }
    __syncthreads();
    const int c = tid & 255, half = tid >> 8;
    float w[31];
#pragma unroll
    for (int j = 0; j < 31; ++j) w[j] = A.conv_w[(size_t)(l * 31 + j) * 256 + c];
    const float bias = A.conv_b[l * 256 + c];
    float win[62];
#pragma unroll
    for (int i = 0; i < 62; ++i) win[i] = Y[(32 * half + i) * 256 + c];
    __syncthreads();
#pragma unroll
    for (int t = 0; t < 32; ++t) { float acc = bias;
#pragma unroll
        for (int j = 0; j < 31; ++j) acc += w[j] * win[t + j];
        Y[(32 * half + t) * 256 + c] = acc; }
    __syncthreads();
    const f32x4 g4 = *(const f32x4*)(A.conv_norm_g + l * 256 + 4 * lane), b4 = *(const f32x4*)(A.conv_norm_b + l * 256 + 4 * lane);
#pragma unroll
    for (int i0 = 0; i0 < 8; i0 += 4) {
        f32x4 v[4]; float sm[4], sq[4];
#pragma unroll
        for (int k = 0; k < 4; ++k) { v[k] = *(const LAS f32x4*)(Y + (wid + 8 * (i0 + k)) * 256 + 4 * lane); sm[k] = (v[k].x + v[k].y) + (v[k].z + v[k].w); }
#pragma unroll
        for (int o_ = 1; o_ < 64; o_ <<= 1) {
#pragma unroll
            for (int k = 0; k < 4; ++k) sm[k] += shx(sm[k], o_);
        }
#pragma unroll
        for (int k = 0; k < 4; ++k) { v[k] = v[k] - sm[k] * (1.0f / 256.0f); sq[k] = (v[k].x * v[k].x + v[k].y * v[k].y) + (v[k].z * v[k].z + v[k].w * v[k].w); }
#pragma unroll
        for (int o_ = 1; o_ < 64; o_ <<= 1) {
#pragma unroll
            for (int k = 0; k < 4; ++k) sq[k] += shx(sq[k], o_);
        }
#pragma unroll
        for (int k = 0; k < 4; ++k) {
            const float rstd = rsqrtf(sq[k] * (1.0f / 256.0f) + EPS);
            f32x4 o = v[k] * rstd * g4 + b4;
            o.x *= fast_sigmoid(o.x); o.y *= fast_sigmoid(o.y); o.z *= fast_sigmoid(o.z); o.w *= fast_sigmoid(o.w);
            v2u wv; wv.x = pk2(o.x, o.y); wv.y = pk2(o.z, o.w);
            *(v2u*)(MIX + ((size_t)b * SEQ + t0 + wid + 8 * (i0 + k)) * DM + 256 + 4 * lane) = wv;
        }
    }
    __syncthreads();
}

__device__ __forceinline__ void gmlp_unit(CA& A, int l, int u, LAS unsigned char* lds) {
    const int tid = otid(), lane = tid & 63, wid = __builtin_amdgcn_readfirstlane(tid >> 6);
    const size_t row0 = (size_t)(u >> 5) * SEQ + (size_t)(u & 31) * 128;
    const bf16_t* Z = (const bf16_t*)(A.ws + WS_Z);
    bf16_t* MIX = (bf16_t*)(A.ws + WS_MIX);
    LAS bf16_t* Vn = (LAS bf16_t*)lds;
    {
        const f32x4 g4 = *(const f32x4*)(A.gmlp_norm_g + l * 256 + 4 * lane), b4 = *(const f32x4*)(A.gmlp_norm_b + l * 256 + 4 * lane);
        v2u raw[16];
#pragma unroll
        for (int i = 0; i < 16; ++i) raw[i] = *(const v2u*)(Z + (row0 + wid + 8 * i) * ZC + GMLP0 + 256 + 4 * lane);
#pragma unroll
        for (int i0 = 0; i0 < 16; i0 += 4) {
            f32x4 v[4]; float sm[4], sq[4];
#pragma unroll
            for (int k = 0; k < 4; ++k) { const v2u rw = raw[i0 + k];
                v[k].x = gelu_tanh(bflo(rw.x)); v[k].y = gelu_tanh(bfhi(rw.x)); v[k].z = gelu_tanh(bflo(rw.y)); v[k].w = gelu_tanh(bfhi(rw.y));
                sm[k] = (v[k].x + v[k].y) + (v[k].z + v[k].w); }
#pragma unroll
            for (int o_ = 1; o_ < 64; o_ <<= 1) {
#pragma unroll
                for (int k = 0; k < 4; ++k) sm[k] += shx(sm[k], o_);
            }
#pragma unroll
            for (int k = 0; k < 4; ++k) { v[k] = v[k] - sm[k] * (1.0f / 256.0f); sq[k] = (v[k].x * v[k].x + v[k].y * v[k].y) + (v[k].z * v[k].z + v[k].w * v[k].w); }
#pragma unroll
            for (int o_ = 1; o_ < 64; o_ <<= 1) {
#pragma unroll
                for (int k = 0; k < 4; ++k) sq[k] += shx(sq[k], o_);
            }
#pragma unroll
            for (int k = 0; k < 4; ++k) {
                const float rstd = rsqrtf(sq[k] * (1.0f / 256.0f) + EPS);
                const f32x4 o = v[k] * rstd * g4 + b4;
                v2u wv; wv.x = pk2(o.x, o.y); wv.y = pk2(o.z, o.w);
                *(LAS v2u*)(Vn + (wid + 8 * (i0 + k)) * 264 + 4 * lane) = wv;
            }
        }
    }
    __syncthreads();
    const int fr = lane & 15, quad = lane >> 4, tt = wid;
    const int nks = (16 * tt + 15) / 32 + 1;
    for (int h = 0; h < 4; ++h) {
        f32x4 wraw[4][2];
#pragma unroll
        for (int ks = 0; ks < 4; ++ks) {
            const float* wp = A.gmlp_ws + ((size_t)(l * 4 + h) * 128 + 16 * tt + fr) * 128 + 32 * ks + quad * 8;
            if (ks < nks) { wraw[ks][0] = *(const f32x4*)wp; wraw[ks][1] = *(const f32x4*)(wp + 4); }
            else { wraw[ks][0] = (f32x4){0.f, 0.f, 0.f, 0.f}; wraw[ks][1] = (f32x4){0.f, 0.f, 0.f, 0.f}; }
        }
        bf16_t uraw[4][4]; float bsv[4];
#pragma unroll
        for (int j = 0; j < 4; ++j) { const int t = 16 * tt + quad * 4 + j; bsv[j] = A.gmlp_bs[(l * 4 + h) * 128 + t];
#pragma unroll
            for (int dt = 0; dt < 4; ++dt) uraw[dt][j] = Z[(row0 + t) * ZC + GMLP0 + h * 64 + 16 * dt + fr]; }
        bf16x8 af[4];
#pragma unroll
        for (int ks = 0; ks < 4; ++ks) {
            const int t = 16 * tt + fr, s0 = 32 * ks + quad * 8;
            float e[8] = {wraw[ks][0][0], wraw[ks][0][1], wraw[ks][0][2], wraw[ks][0][3], wraw[ks][1][0], wraw[ks][1][1], wraw[ks][1][2], wraw[ks][1][3]};
#pragma unroll
            for (int j = 0; j < 8; ++j) if (s0 + j > t) e[j] = 0.f;
            v4u w; w.x = pk2(e[0], e[1]); w.y = pk2(e[2], e[3]); w.z = pk2(e[4], e[5]); w.w = pk2(e[6], e[7]);
            af[ks] = __builtin_bit_cast(bf16x8, w);
        }
#pragma unroll
        for (int dt = 0; dt < 4; ++dt) {
            const int ch = h * 64 + 16 * dt + fr;
            f32x4 acc = {0.f, 0.f, 0.f, 0.f};
#pragma unroll
            for (int ks = 0; ks < 4; ++ks) {
                if (ks < nks) {
                    bf16x8 bfr;
#pragma unroll
                    for (int j = 0; j < 8; ++j) bfr[j] = (short)Vn[(32 * ks + quad * 8 + j) * 264 + ch];
                    acc = __builtin_amdgcn_mfma_f32_16x16x32_bf16(af[ks], bfr, acc, 0, 0, 0);
                }
            }
#pragma unroll
            for (int j = 0; j < 4; ++j) {
                const int t = 16 * tt + quad * 4 + j;
                MIX[(row0 + t) * DM + 512 + ch] = (bf16_t)f2bf(gelu_tanh(bf2f(uraw[dt][j])) * (acc[j] + bsv[j]));
            }
        }
    }
    __syncthreads();
}

constexpr int MIX_ATT_ITEMS = 768, MIX_CONV_ITEMS = 256, MIX_GMLP_ITEMS = 128, MIX_ITEMS = MIX_ATT_ITEMS + MIX_CONV_ITEMS + MIX_GMLP_ITEMS;
__device__ __forceinline__ void mix_phase(CA& A0, int l, LAS unsigned char* lds) {
    const int tid = otid();
    unsigned* counter = (unsigned*)(A0.ws + WS_CTL) + 64 * l;
    volatile LAS int* slot = (volatile LAS int*)(lds + LDS_MAIN);
    float lam_init = 0.8f - 0.6f * expf(-0.3f * (float)l), lam;
    { const float* lv = A0.diff_lambda + l * 128; float s1 = 0.f, s2 = 0.f;
      for (int i = 0; i < 32; ++i) { s1 += lv[i] * lv[32 + i]; s2 += lv[64 + i] * lv[96 + i]; }
      lam = expf(s1) - expf(s2) + lam_init; }
    for (;;) {
        __syncthreads();
        if (tid == 0) *slot = (int)atomicAdd(counter, 1u);
        __syncthreads();
        const int it = *slot;
        if (it >= MIX_ITEMS) break;
        asm volatile("" : "+s"(l));
        CA* Pq = &A0; asm volatile("" : "+s"(Pq)); CA& A = *Pq;
        int ait = -1;
        if (it < 256) ait = it; else if (it >= 256 + MIX_GMLP_ITEMS + MIX_CONV_ITEMS) ait = it - MIX_GMLP_ITEMS - MIX_CONV_ITEMS;
        if (ait >= 0) {
            const int level = 15 - ait / 48, r = ait % 48, grp = r / 16, bh = r % 16;
            if (grp == 0) {
 attn_unit<false>(A, l, bh >> 2, bh & 3, level, lds, lam, lam_init);
 }
            else {
 attn_unit<true>(A, l, bh >> 2, bh & 3, grp == 1 ? 2 * level + 1 : 2 * level, lds, lam, lam_init);
 }
        } else if (it < 256 + MIX_GMLP_ITEMS) {
 gmlp_unit(A, l, it - 256, lds);
 }
        else {
 conv_unit(A, l, it - 256 - MIX_GMLP_ITEMS, lds);
 }
    }
}

__global__ void __launch_bounds__(512, 2) fwd_kernel(Args A_unused) {
    CA* const P0 = (CA*)__builtin_amdgcn_kernarg_segment_ptr();
    extern __shared__ __attribute__((aligned(16))) unsigned char lds_raw[];
    LAS unsigned char* lds = (LAS unsigned char*)lds_raw;
    cg::grid_group grid = cg::this_grid();
    const int ph_lo = P0->ph_lo, ph_hi = P0->ph_hi;
    if (threadIdx.x < 16) ((LAS unsigned*)(lds + LDS_MAIN))[threadIdx.x] = 0u;
    __syncthreads();
    XcdBarrier xbar = xcd_barrier_post((unsigned*)(P0->ws + WS_XBAR), (volatile LAS unsigned*)(lds + LDS_MAIN + 16));
    for (int ph = ph_lo; ph < ph_hi; ++ph) {
        CA* P = P0; asm volatile("" : "+s"(P)); CA& A = *P;
        bf16_t* XN = (bf16_t*)(A.ws + WS_XN); bf16_t* ACT = (bf16_t*)(A.ws + WS_ACT); bf16_t* Zp = (bf16_t*)(A.ws + WS_Z); bf16_t* MIXp = (bf16_t*)(A.ws + WS_MIX);
        const float* MOD = (const float*)(A.ws + WS_MOD);
        if (ph == 0) { p0_prologue(A, lds); }
        else if (ph == 1) { p1_phase(A); }
        else {
            int l = (ph - 2) / 7, s = (ph - 2) % 7;
            asm volatile("" : "+s"(l), "+s"(s));
            if (s == 3) { cum_scan(A, l, lds); mix_phase(A, l, lds); }
            else {
                const bf16_t* Ap; const bf16_t* Bt; int N, K; EpiAll E{(const void*)P0, l, s};
                if (s == 0 || s == 5) { Ap = XN; Bt = (const bf16_t*)(A.ws + (s == 0 ? WS_W1IN : WS_W2IN)) + (size_t)l * 2 * DFF * DM; N = 2 * DFF; K = DM; }
                else if (s == 2) { Ap = XN; Bt = (const bf16_t*)(A.ws + WS_WIN) + (size_t)l * ZN * DM; N = ZN; K = DM; }
                else { Ap = (s == 4) ? MIXp : ACT;
                    Bt = (s == 4) ? (const bf16_t*)(A.ws + WS_WOUT) + (size_t)l * DM * DM : (const bf16_t*)(A.ws + (s == 1 ? WS_W1OUT : WS_W2OUT)) + (size_t)l * DM * DFF;
                    N = DM; K = (s == 4) ? DM : DFF; }
                pg8::Gemm g{Ap, Bt, M, N, K}; pg8::StaticOrder S; S.init(M, N, (int)gridDim.x, (int)blockIdx.x);
                pg8::gemm_phase<EpiAll, pg8::StaticOrder, true, true>(lds, g, S, E);
                if (s == 1 || s == 4 || s == 6) fused_norm_tail(A, l, s);
                if (gridDim.x == 256) {
                    constexpr int R_F1OUT = 2 * I_FIN, R_F2OUT = R_F1OUT + I_FOUT, R_WIN = R_F2OUT + I_FOUT, R_WOUT = R_WIN + I_WIN;
                    const int wvx = (int)__builtin_amdgcn_readfirstlane(threadIdx.x >> 6);
                    if ((s == 0 || s == 5) && blockIdx.x >= 128) {
                        const int wv_ = (int)(blockIdx.x - 128) * 8 + wvx;
                        if (l == 0 && s == 0) weight_copies(A, lds, I_LAYER, I_LAYER + I_FIN, wv_, 128 * 8);
                        if (l == 0 && s == 5) { weight_copies(A, lds, I_LAYER + R_F1OUT, I_LAYER + R_F2OUT, wv_, 128 * 8);
                                                weight_copies(A, lds, I_LAYER + R_WIN, I_LAYER + R_WOUT, wv_, 128 * 8); }
                        if (l == 1 && s == 0) weight_copies(A, lds, I_LAYER + I_FIN, I_LAYER + 2 * I_FIN, wv_, 128 * 8);
                    } else if (l == 1 && s == 2 && blockIdx.x >= 192) {
                        const int wv_ = (int)(blockIdx.x - 192) * 8 + wvx;
                        weight_copies(A, lds, I_LAYER + R_F2OUT, I_LAYER + R_WIN, wv_, 64 * 8);
                        weight_copies(A, lds, I_LAYER + R_WOUT, 2 * I_LAYER, wv_, 64 * 8);
                    }
                }
            }
        }
        if (ph + 1 < ph_hi) {
            if (ph_lo < 0) grid.sync();
            xcd_barrier(xbar);
        }
    }
}

extern "C" void kernel_launch(void* const* d_in, const int* in_sizes, int n_in, void* d_out, int out_size, void* d_ws, size_t ws_size, hipStream_t stream) {
    static int grid_blocks = 0;
    if (grid_blocks == 0) {
        if (n_in != 24 || out_size != M * DM || ws_size < WS_END) { fprintf(stderr, "kernel_launch: unexpected problem (n_in %d out %d ws %zu)\n", n_in, out_size, ws_size); grid_blocks = -1; return; }
        int dev = 0, cus = 0, per_cu = 0;
        hipGetDevice(&dev);
        hipDeviceGetAttribute(&cus, hipDeviceAttributeMultiprocessorCount, dev);
        hipFuncSetAttribute((const void*)fwd_kernel, hipFuncAttributeMaxDynamicSharedMemorySize, LDS_BYTES);
        hipOccupancyMaxActiveBlocksPerMultiprocessor(&per_cu, (const void*)fwd_kernel, 512, LDS_BYTES);
        if (per_cu < 1) { fprintf(stderr, "kernel_launch: occupancy query says %d blocks per CU\n", per_cu); per_cu = 1; }
        (void)hipGetLastError();
        grid_blocks = cus;
    }
    if (grid_blocks < 0) return;
    hipMemsetAsync((char*)d_ws + WS_CTL, 0, CTL_BYTES, stream);
    hipMemsetAsync((char*)d_ws + WS_MOD, 0, (size_t)DEPTH * 4 * NMODC * sizeof(float), stream);
    Args a{};
    const float** ap = (const float**)&a;
    for (int i = 0; i < 24; ++i) ap[i] = (const float*)d_in[i];
    a.out = (float*)d_out; a.ws = (unsigned char*)d_ws;
#if MK_ONE_LAUNCH
    a.ph_lo = 0; a.ph_hi = NPHASE;
    void* args[] = {&a};
    hipError_t e = hipLaunchCooperativeKernel((const void*)fwd_kernel, dim3(grid_blocks), dim3(512), args, LDS_BYTES, stream);
    if (e != hipSuccess) fprintf(stderr, "cooperative launch failed: %s (grid %d)\n", hipGetErrorString(e), grid_blocks);
#else
    for (int ph = 0; ph < NPHASE; ++ph) { a.ph_lo = ph; a.ph_hi = ph + 1; hipLaunchKernelGGL(fwd_kernel, dim3(grid_blocks), dim3(512), LDS_BYTES, stream, a); }
#endif
}
```
